# Optimizing an MI355X kernel written in HIP

```python
import math
import jax, jax.numpy as jnp
from jax import lax
import numpy as np

D_MODEL = 2048
BATCH = 1
SEQ = 16384
DEPTH = 4

N_MIXERS = 2
N_DIFF_LAYERS = (DEPTH + 1) // 2
N_RET_LAYERS = DEPTH // 2

D_FF = 5632
FFN_RESIDUAL_WEIGHT = 0.5
NORM_EPS = 1e-6

DA_HEAD_DIM = 64
DA_HEADS = D_MODEL // (2 * DA_HEAD_DIM)
ROPE_DIM = DA_HEAD_DIM // 4
ROPE_THETA = 500000.0
Q_BLOCK = 128

RET_HEADS = 8
RET_KEY_DIM = D_MODEL // RET_HEADS
RET_VAL_DIM = 2 * RET_KEY_DIM
RET_THETA = 10000.0
RET_CHUNK = 128

kernel_name = "hybrid_diffattn_retention_macaron"


def rms_norm(x, g):
    xf = x.astype(jnp.float32)
    y = xf * lax.rsqrt(jnp.mean(xf * xf, axis=-1, keepdims=True) + NORM_EPS)
    return (y * g.astype(jnp.float32)).astype(x.dtype)


def swiglu(x, w_gate, w_up, w_down):
    return (jax.nn.silu(x @ w_gate) * (x @ w_up)) @ w_down


def partial_rope(x, pos):
    half = ROPE_DIM // 2
    inv_freq = ROPE_THETA ** (-jnp.arange(0, ROPE_DIM, 2, dtype=jnp.float32) / ROPE_DIM)
    ang = pos[:, None] * inv_freq[None, :]
    bshape = (ang.shape[0],) + (1,) * (x.ndim - 3) + (half,)
    cos = jnp.cos(ang).reshape(bshape)
    sin = jnp.sin(ang).reshape(bshape)
    xf = x.astype(jnp.float32)
    x1, x2, rest = xf[..., :half], xf[..., half:ROPE_DIM], xf[..., ROPE_DIM:]
    out = jnp.concatenate([x1 * cos - x2 * sin, x2 * cos + x1 * sin, rest], axis=-1)
    return out.astype(x.dtype)


def diff_attention(h, w_q, w_k, w_v, w_o, q_norm, k_norm,
                   lam_q1, lam_k1, lam_q2, lam_k2, sub_norm, lambda_init):
    B, T, _ = h.shape
    f32 = jnp.float32
    pos = jnp.arange(T, dtype=f32)
    q = (h @ w_q).reshape(B, T, DA_HEADS, 2, DA_HEAD_DIM)
    k = (h @ w_k).reshape(B, T, DA_HEADS, 2, DA_HEAD_DIM)
    v = (h @ w_v).reshape(B, T, DA_HEADS, 2 * DA_HEAD_DIM)
    q = partial_rope(rms_norm(q, q_norm), pos)
    k = partial_rope(rms_norm(k, k_norm), pos)
    lam = (jnp.exp(jnp.sum(lam_q1.astype(f32) * lam_k1.astype(f32)))
           - jnp.exp(jnp.sum(lam_q2.astype(f32) * lam_k2.astype(f32)))
           + lambda_init)
    scale = DA_HEAD_DIM ** -0.5
    k_pos = jnp.arange(T)

    def block(i):
        start = i * Q_BLOCK
        qb = lax.dynamic_slice_in_dim(q, start, Q_BLOCK, axis=1)
        s = jnp.einsum('bqhcd,bkhcd->bhcqk', qb, k,
                       preferred_element_type=f32) * scale
        q_pos = start + jnp.arange(Q_BLOCK)
        s = jnp.where(k_pos[None, :] <= q_pos[:, None], s, -jnp.inf)
        p = jax.nn.softmax(s, axis=-1)
        a = p[:, :, 0] - lam * p[:, :, 1]
        return jnp.einsum('bhqk,bkhe->bqhe', a.astype(v.dtype), v)

    o = lax.map(block, jnp.arange(T // Q_BLOCK))
    o = jnp.moveaxis(o, 0, 1).reshape(B, T, DA_HEADS, 2 * DA_HEAD_DIM)
    o = rms_norm(o, sub_norm) * (1.0 - lambda_init)
    return o.reshape(B, T, DA_HEADS * 2 * DA_HEAD_DIM) @ w_o


def ret_rotate(x, pos):
    half = x.shape[-1] // 2
    angle = 1.0 / (RET_THETA ** jnp.linspace(0.0, 1.0, half, dtype=jnp.float32))
    ang = pos[:, None] * angle[None, :]
    cos = jnp.cos(ang)[:, None, :]
    sin = jnp.sin(ang)[:, None, :]
    xp = x.reshape(x.shape[:-1] + (half, 2))
    x1, x2 = xp[..., 0], xp[..., 1]
    out = jnp.stack([x1 * cos - x2 * sin, x2 * cos + x1 * sin], axis=-1)
    return out.reshape(x.shape)


def retention(h, w_q, w_k, w_v, w_g, w_o):
    B, T, _ = h.shape
    f32 = jnp.float32
    C = RET_CHUNK
    nc = T // C
    pos = jnp.arange(T, dtype=f32)
    q = ret_rotate((h @ w_q).reshape(B, T, RET_HEADS, RET_KEY_DIM).astype(f32), pos)
    k = ret_rotate((h @ w_k).reshape(B, T, RET_HEADS, RET_KEY_DIM).astype(f32), pos) * (RET_KEY_DIM ** -0.5)
    v = (h @ w_v).reshape(B, T, RET_HEADS, RET_VAL_DIM).astype(f32)

    log_g = jnp.log1p(-jnp.exp2(-5.0 - jnp.arange(RET_HEADS, dtype=f32)))
    n = jnp.arange(C, dtype=f32)
    diff = n[:, None] - n[None, :]
    decay_intra = jnp.where(diff[None] >= 0,
                            jnp.exp(jnp.maximum(diff, 0.0)[None] * log_g[:, None, None]), 0.0)
    xi = jnp.exp((n[:, None] + 1.0) * log_g[None, :])[None, :, :, None]
    zeta = jnp.exp((C - 1.0 - n[:, None]) * log_g[None, :])[None, :, :, None]
    chunk_decay = jnp.exp(C * log_g)[None, :, None, None]

    qc = q.reshape(B, nc, C, RET_HEADS, RET_KEY_DIM)
    kc = k.reshape(B, nc, C, RET_HEADS, RET_KEY_DIM)
    vc = v.reshape(B, nc, C, RET_HEADS, RET_VAL_DIM)

    s = jnp.einsum('bcnhd,bcmhd->bchnm', qc, kc) * decay_intra[None, None]
    inner = jnp.einsum('bchnm,bcmhe->bcnhe', s, vc)

    def step(R, xs):
        qi, ki, vi = xs
        cross = jnp.einsum('bnhd,bhde->bnhe', qi, R) * xi
        R = R * chunk_decay + jnp.einsum('bmhd,bmhe->bhde', ki * zeta, vi)
        return R, cross

    R0 = jnp.zeros((B, RET_HEADS, RET_KEY_DIM, RET_VAL_DIM), f32)
    _, cross = lax.scan(step, R0, (jnp.moveaxis(qc, 1, 0), jnp.moveaxis(kc, 1, 0), jnp.moveaxis(vc, 1, 0)))
    y = (inner + jnp.moveaxis(cross, 0, 1)).reshape(B, T, RET_HEADS, RET_VAL_DIM)

    mu = jnp.mean(y, axis=-1, keepdims=True)
    var = jnp.mean(jnp.square(y - mu), axis=-1, keepdims=True)
    y = ((y - mu) * lax.rsqrt(var + NORM_EPS)).reshape(B, T, RET_HEADS * RET_VAL_DIM).astype(h.dtype)
    return (jax.nn.silu(h @ w_g) * y) @ w_o


def setup_inputs(seed: int = 0) -> dict:
    key = jax.random.key(seed)
    ks = iter(jax.random.split(key, 32))
    f32 = jnp.float32

    def w(shape, fan_in):
        return jax.random.normal(next(ks), shape, f32) * (fan_in ** -0.5)

    def gain(shape):
        return 1.0 + 0.02 * jax.random.normal(next(ks), shape, f32)

    D, F = D_MODEL, D_FF
    Ld, Lr = N_DIFF_LAYERS, N_RET_LAYERS
    da_w = DA_HEADS * 2 * DA_HEAD_DIM
    r_k = RET_HEADS * RET_KEY_DIM
    r_v = RET_HEADS * RET_VAL_DIM
    return {
        "x": jax.random.normal(next(ks), (BATCH, SEQ, D), f32),
        "ffn1_norm": gain((DEPTH, D)),
        "ffn1_w_gate": w((DEPTH, D, F), D),
        "ffn1_w_up": w((DEPTH, D, F), D),
        "ffn1_w_down": w((DEPTH, F, D), F),
        "mix_norm": gain((DEPTH, D)),
        "da_w_q": w((Ld, D, da_w), D),
        "da_w_k": w((Ld, D, da_w), D),
        "da_w_v": w((Ld, D, da_w), D),
        "da_w_o": w((Ld, da_w, D), da_w),
        "da_q_norm": gain((Ld, DA_HEAD_DIM)),
        "da_k_norm": gain((Ld, DA_HEAD_DIM)),
        "da_lam_q1": 0.1 * jax.random.normal(next(ks), (Ld, DA_HEAD_DIM), f32),
        "da_lam_k1": 0.1 * jax.random.normal(next(ks), (Ld, DA_HEAD_DIM), f32),
        "da_lam_q2": 0.1 * jax.random.normal(next(ks), (Ld, DA_HEAD_DIM), f32),
        "da_lam_k2": 0.1 * jax.random.normal(next(ks), (Ld, DA_HEAD_DIM), f32),
        "da_sub_norm": gain((Ld, 2 * DA_HEAD_DIM)),
        "ret_w_q": w((Lr, D, r_k), D),
        "ret_w_k": w((Lr, D, r_k), D),
        "ret_w_v": w((Lr, D, r_v), D),
        "ret_w_g": w((Lr, D, r_v), D),
        "ret_w_o": w((Lr, r_v, D), r_v),
        "ffn2_norm": gain((DEPTH, D)),
        "ffn2_w_gate": w((DEPTH, D, F), D),
        "ffn2_w_up": w((DEPTH, D, F), D),
        "ffn2_w_down": w((DEPTH, F, D), F),
    }


def reference(x, ffn1_norm, ffn1_w_gate, ffn1_w_up, ffn1_w_down, mix_norm,
              da_w_q, da_w_k, da_w_v, da_w_o, da_q_norm, da_k_norm,
              da_lam_q1, da_lam_k1, da_lam_q2, da_lam_k2, da_sub_norm,
              ret_w_q, ret_w_k, ret_w_v, ret_w_g, ret_w_o,
              ffn2_norm, ffn2_w_gate, ffn2_w_up, ffn2_w_down):
    for i in range(DEPTH):
        x = x + FFN_RESIDUAL_WEIGHT * swiglu(rms_norm(x, ffn1_norm[i]),
                                             ffn1_w_gate[i], ffn1_w_up[i], ffn1_w_down[i])
        h = rms_norm(x, mix_norm[i])
        j = i // N_MIXERS
        if i % N_MIXERS == 0:
            lambda_init = 0.8 - 0.6 * math.exp(-0.3 * i)
            y = diff_attention(h, da_w_q[j], da_w_k[j], da_w_v[j], da_w_o[j],
                               da_q_norm[j], da_k_norm[j],
                               da_lam_q1[j], da_lam_k1[j], da_lam_q2[j], da_lam_k2[j],
                               da_sub_norm[j], lambda_init)
        else:
            y = retention(h, ret_w_q[j], ret_w_k[j], ret_w_v[j], ret_w_g[j], ret_w_o[j])
        x = x + y
        x = x + FFN_RESIDUAL_WEIGHT * swiglu(rms_norm(x, ffn2_norm[i]),
                                             ffn2_w_gate[i], ffn2_w_up[i], ffn2_w_down[i])
    return x
```

```cpp
#include <hip/hip_runtime.h>
#include <hip/hip_bf16.h>
#include <cstdio>
#include <cstdint>
#include <cmath>
namespace pg8 {
#define PG8_LAS __attribute__((address_space(3)))
typedef unsigned short bf16_t;
typedef short bf16x8 __attribute__((ext_vector_type(8)));
typedef float f32x4 __attribute__((ext_vector_type(4)));
typedef unsigned u32x4 __attribute__((ext_vector_type(4)));
constexpr int BM = 256, BK = 64, HALF = 128, HTB = HALF * BK * 2  , STAGE_BYTES = 8 * HTB, NXCD = 8, WGM = 8;

__host__ __device__ __forceinline__ int lds_byte(int r, int c) { const int st = (r >> 4) * 2 + (c >> 5), rr = r & 15, cc = c & 31, ob = rr * 64 + cc * 2; return st * 1024 + (ob ^ (((ob >> 9) & 1) << 5)); }
__host__ __device__ __forceinline__ void stage_rc(int b, int& R, int& C) { const int st = b / 1024, sb = b % 1024, swz = sb ^ (((sb >> 9) & 1) << 5); R = (st >> 1) * 16 + swz / 64; C = (st & 1) * 32 + (swz % 64) / 2; }
__host__ __device__ __forceinline__ int perm32(int rho) { const int n = rho >> 4, i = rho & 15; return 8 * (i >> 2) + 4 * n + (i & 3); }

struct Unit { int pm, pn; };
struct Gemm { const bf16_t* A; const bf16_t* Bt; int M, N, K; };

struct StaticOrder {
    int nM, nN, nwg, G, c;
    __host__ __device__ void init(int M, int N, int G_, int c_) { nM = M / BM; nN = N / BM; nwg = nM * nN; G = G_; c = c_; }
    __host__ __device__ bool next(int i, Unit& u) const {
        const long L = (long)i * G + c; if (L >= nwg) return false;
        int wgid = (int)L; { const int q = nwg / NXCD, r = nwg % NXCD, xcd = wgid % NXCD, off = wgid / NXCD; wgid = (xcd < r ? xcd * (q + 1) : r * (q + 1) + (xcd - r) * q) + off; }
        const int nig = WGM * nN, gid = wgid / nig, fm = gid * WGM, gsz = (nM - fm) < WGM ? (nM - fm) : WGM;
        u.pm = fm + ((wgid % nig) % gsz); u.pn = (wgid % nig) / gsz; return true;
    }
    __device__ __forceinline__ void a_ready(const Unit&) const {}
    __device__ __forceinline__ void done(const Unit&) const {}
};

__device__ __forceinline__ unsigned cvt_pk_bf16(float lo, float hi) { unsigned r; asm volatile("v_cvt_pk_bf16_f32 %0, %1, %2" : "=v"(r) : "v"(lo), "v"(hi)); return r; }
typedef float f32x2 __attribute__((ext_vector_type(2)));
typedef unsigned u32x2 __attribute__((ext_vector_type(2)));
__device__ __forceinline__ float silu_f(float g) { return g * __builtin_amdgcn_rcpf(1.0f + __builtin_amdgcn_exp2f(-1.4426950408889634f * g)); }
__device__ __forceinline__ u32x4 pack8(const f32x4 a, const f32x4 b) { u32x4 w; w.x = cvt_pk_bf16(a[0], a[1]); w.y = cvt_pk_bf16(a[2], a[3]); w.z = cvt_pk_bf16(b[0], b[1]); w.w = cvt_pk_bf16(b[2], b[3]); return w; }
__device__ __forceinline__ bf16_t f2bf1(float f) { return (bf16_t)(cvt_pk_bf16(f, 0.f) & 0xffffu); }

struct EpiSwiGLU {
    static constexpr bool PERM = true, AFTER_DRAIN = false;
    bf16_t* O; int ldc;
    __device__ __forceinline__ void operator()(const f32x4 (&acc)[2][2][4][2], const Unit& u, int wr, int wc, int fr, int fq) const {
        const int row0 = u.pm * BM + wr * 64 + fr, col0 = u.pn * HALF + wc * 32 + 8 * fq;
#pragma unroll
        for (int ai = 0; ai < 2; ++ai)
#pragma unroll
            for (int m = 0; m < 4; ++m) {
                f32x4 v0, v1;
#pragma unroll
                for (int j = 0; j < 4; ++j) { v0[j] = silu_f(acc[ai][0][m][0][j]) * acc[ai][1][m][0][j]; v1[j] = silu_f(acc[ai][0][m][1][j]) * acc[ai][1][m][1][j]; }
                *(u32x4*)(O + (size_t)(row0 + ai * HALF + m * 16) * ldc + col0) = pack8(v0, v1);
            }
    }
};
struct EpiResid {
    static constexpr bool PERM = false, AFTER_DRAIN = false;
    const float* base; float* out; int ldc; float scale;
    __device__ __forceinline__ void operator()(const f32x4 (&acc)[2][2][4][2], const Unit& u, int wr, int wc, int fr, int fq) const {
        const int row0 = u.pm * BM + wr * 64 + fr, col0 = u.pn * BM + wc * 32 + 4 * fq;
#pragma unroll
        for (int ai = 0; ai < 2; ++ai)
#pragma unroll
            for (int m = 0; m < 4; ++m) { const size_t off = (size_t)(row0 + ai * HALF + m * 16) * ldc + col0;
#pragma unroll
                for (int bj = 0; bj < 2; ++bj)
#pragma unroll
                    for (int n = 0; n < 2; ++n) { const f32x4 b = *(const f32x4*)(base + off + bj * HALF + n * 16); *(f32x4*)(out + off + bj * HALF + n * 16) = b + acc[ai][bj][m][n] * scale; } }
    }
};
struct EpiQKVDiff {
    static constexpr bool PERM = true, AFTER_DRAIN = false;
    bf16_t *Q, *K, *V; const float* qg; const float* kg; const float* rope; float qscale;
    __device__ __forceinline__ void operator()(const f32x4 (&acc)[2][2][4][2], const Unit& u, int wr, int wc, int fr, int fq) const {
        const int sec = u.pn >> 3, colbase = (u.pn & 7) * 256 + wc * 64 + 8 * fq, row0 = u.pm * BM + wr * 64 + fr;
        if (sec == 2) {
#pragma unroll
            for (int ai = 0; ai < 2; ++ai)
#pragma unroll
                for (int m = 0; m < 4; ++m) { bf16_t* rp = V + (size_t)(row0 + ai * HALF + m * 16) * 2048 + colbase;
#pragma unroll
                    for (int bj = 0; bj < 2; ++bj) *(u32x4*)(rp + 32 * bj) = pack8(acc[ai][bj][m][0], acc[ai][bj][m][1]); }
        } else {
            const float* gp = sec == 0 ? qg : kg; bf16_t* dst = sec == 0 ? Q : K; const float sc = sec == 0 ? qscale : 1.0f;
            f32x4 gv[2][2];
#pragma unroll
            for (int bj = 0; bj < 2; ++bj)
#pragma unroll
                for (int n = 0; n < 2; ++n) gv[bj][n] = *(const f32x4*)(gp + 32 * bj + 8 * fq + 4 * n) * sc;
            const float sgn = (fq == 0) ? -1.0f : 1.0f; const bool rot = fq < 2;
#pragma unroll
            for (int ai = 0; ai < 2; ++ai)
#pragma unroll
                for (int m = 0; m < 4; ++m) {
                    const int row = row0 + ai * HALF + m * 16;
                    const f32x4* tr = (const f32x4*)(rope + (size_t)row * 16);
                    const f32x4 t0 = tr[0], t1 = tr[1], t2 = tr[2], t3 = tr[3];
                    f32x4 a00 = acc[ai][0][m][0], a01 = acc[ai][0][m][1], a10 = acc[ai][1][m][0], a11 = acc[ai][1][m][1];
                    float ss = 0.f;
#pragma unroll
                    for (int j = 0; j < 4; ++j) ss += a00[j] * a00[j] + a01[j] * a01[j] + a10[j] * a10[j] + a11[j] * a11[j];
                    ss += __shfl_xor(ss, 16); ss += __shfl_xor(ss, 32);
                    const float rs = __builtin_amdgcn_rsqf(ss * (1.0f / 64.0f) + 1e-6f);
                    f32x4 y00 = a00 * rs * gv[0][0], y01 = a01 * rs * gv[0][1]; const f32x4 y10 = a10 * rs * gv[1][0], y11 = a11 * rs * gv[1][1];
                    f32x4 p0, p1;
#pragma unroll
                    for (int j = 0; j < 4; ++j) { p0[j] = __shfl_xor(y00[j], 16); p1[j] = __shfl_xor(y01[j], 16); }
                    f32x4 r0, r1;
                    r0[0] = y00[0] * t0[0] + sgn * p0[0] * t0[1]; r0[1] = y00[1] * t0[2] + sgn * p0[1] * t0[3];
                    r0[2] = y00[2] * t1[0] + sgn * p0[2] * t1[1]; r0[3] = y00[3] * t1[2] + sgn * p0[3] * t1[3];
                    r1[0] = y01[0] * t2[0] + sgn * p1[0] * t2[1]; r1[1] = y01[1] * t2[2] + sgn * p1[1] * t2[3];
                    r1[2] = y01[2] * t3[0] + sgn * p1[2] * t3[1]; r1[3] = y01[3] * t3[2] + sgn * p1[3] * t3[3];
                    if (rot) { y00 = r0; y01 = r1; }
                    bf16_t* rp = dst + (size_t)row * 2048 + colbase;
                    *(u32x4*)(rp) = pack8(y00, y01); *(u32x4*)(rp + 32) = pack8(y10, y11);
                }
        }
    }
};
struct EpiRetProj {
    static constexpr bool PERM = true, AFTER_DRAIN = false;
    bf16_t *QR, *KR, *KZT, *VT, *GS; const float* tab; int Mrows;
    __device__ __forceinline__ static float log2gamma(int h) {
        return h == 0 ? -0.045803689613124789f : h == 1 ? -0.022720076500083529f : h == 2 ? -0.011315313227834146f : h == 3 ? -0.0056465631411420627f :
               h == 4 ? -0.0028205190623786626f : h == 5 ? -0.0014095702546713536f : h == 6 ? -0.00070461297658937271f : -0.00035226347162902138f;
    }
    __device__ __forceinline__ void operator()(const f32x4 (&acc)[2][2][4][2], const Unit& u, int wr, int wc, int fr, int fq) const {
        const int pn = u.pn, row0 = u.pm * BM + wr * 64 + fr, cl = wc * 32 + 8 * fq;
        if (pn < 16) {
            const bool isk = pn >= 8; const int h = pn & 7; const float sc = isk ? 0.0625f : 1.0f; bf16_t* dst = isk ? KR : QR; const float l2g = log2gamma(h);
#pragma unroll
            for (int ai = 0; ai < 2; ++ai)
#pragma unroll
                for (int m = 0; m < 4; ++m) {
                    const int row = row0 + ai * HALF + m * 16;
                    const float zeta = __builtin_amdgcn_exp2f(l2g * (float)(127 - (row & 127)));
#pragma unroll
                    for (int bj = 0; bj < 2; ++bj) {
                        const int dim0 = 128 * bj + cl;
                        const f32x4* tp = (const f32x4*)(tab + ((size_t)row * 128 + (dim0 >> 1)) * 2);
                        const f32x4 t0 = tp[0], t1 = tp[1];
                        const f32x4 a0 = acc[ai][bj][m][0], a1 = acc[ai][bj][m][1];
                        f32x4 r0, r1;
                        r0[0] = a0[0] * t0[0] - a0[1] * t0[1]; r0[1] = a0[1] * t0[0] + a0[0] * t0[1];
                        r0[2] = a0[2] * t0[2] - a0[3] * t0[3]; r0[3] = a0[3] * t0[2] + a0[2] * t0[3];
                        r1[0] = a1[0] * t1[0] - a1[1] * t1[1]; r1[1] = a1[1] * t1[0] + a1[0] * t1[1];
                        r1[2] = a1[2] * t1[2] - a1[3] * t1[3]; r1[3] = a1[3] * t1[2] + a1[2] * t1[3];
                        r0 = r0 * sc; r1 = r1 * sc;
                        *(u32x4*)(dst + (size_t)row * 2048 + 256 * h + dim0) = pack8(r0, r1);
                        if (isk) { bf16_t* zp = KZT + (size_t)(256 * h + dim0) * Mrows + row;
#pragma unroll
                            for (int j = 0; j < 4; ++j) { zp[(size_t)j * Mrows] = f2bf1(r0[j] * zeta); zp[(size_t)(4 + j) * Mrows] = f2bf1(r1[j] * zeta); } }
                    }
                }
        } else if (pn < 32) {
#pragma unroll
            for (int ai = 0; ai < 2; ++ai)
#pragma unroll
                for (int m = 0; m < 4; ++m) {
                    const int row = row0 + ai * HALF + m * 16;
#pragma unroll
                    for (int bj = 0; bj < 2; ++bj) { bf16_t* vp = VT + (size_t)((pn - 16) * 256 + 128 * bj + cl) * Mrows + row;
#pragma unroll
                        for (int j = 0; j < 4; ++j) { vp[(size_t)j * Mrows] = f2bf1(acc[ai][bj][m][0][j]); vp[(size_t)(4 + j) * Mrows] = f2bf1(acc[ai][bj][m][1][j]); } }
                }
        } else {
#pragma unroll
            for (int ai = 0; ai < 2; ++ai)
#pragma unroll
                for (int m = 0; m < 4; ++m) {
                    const int row = row0 + ai * HALF + m * 16;
#pragma unroll
                    for (int bj = 0; bj < 2; ++bj) { f32x4 v0, v1;
#pragma unroll
                        for (int j = 0; j < 4; ++j) { v0[j] = silu_f(acc[ai][bj][m][0][j]); v1[j] = silu_f(acc[ai][bj][m][1][j]); }
                        *(u32x4*)(GS + (size_t)row * 4096 + (pn - 32) * 256 + 128 * bj + cl) = pack8(v0, v1); }
                }
        }
    }
};
template <class Epi, class Sched, bool ALIGN_EPI = false, bool SP2 = false>
__device__ __forceinline__ void gemm_phase(PG8_LAS unsigned char* lds, const Gemm g, const Sched& S, const Epi& E) {
    int tid_ = threadIdx.x; asm volatile("" : "+v"(tid_));
    const int tid = tid_, wid = __builtin_amdgcn_readfirstlane(tid >> 6), lane = tid & 63, wr = wid >> 2, wc = wid & 3, fr = lane & 15, fq = lane >> 4;
    const int K = g.K, nt = K / BK;
    unsigned voffA[2], voffB[2];
#pragma unroll
    for (int i = 0; i < 2; ++i) { int R, C; stage_rc(tid * 16 + i * 8192, R, C); const int Rb = Epi::PERM ? ((R & ~31) + perm32(R & 31)) : R;
        voffA[i] = (unsigned)(R * K + C) * 2u; voffB[i] = (unsigned)(Rb * K + C) * 2u; }
    const size_t kstep = (size_t)(BK * 2);
    const size_t hstep = (size_t)HALF * K * 2;
    const size_t tstep = 2 * hstep;
    const unsigned ldsw = (unsigned)wid * 1024u;
    const int aoff = lds_byte(wr * 64 + fr, fq * 8), boff = lds_byte(wc * 32 + fr, fq * 8);
#define PG8_SA(b, h) (((b) * 2 + (h)) * HTB)
#define PG8_SB(b, h) ((4 + (b) * 2 + (h)) * HTB)
#define PG8_STAGE(bufoff, gbase, voff) do { _Pragma("unroll") for (int _i = 0; _i < 2; ++_i) \
        __builtin_amdgcn_global_load_lds((const unsigned*)((const char*)(gbase) + (voff)[_i]), (PG8_LAS unsigned*)(lds + (bufoff) + ldsw + _i * 8192), 16, 0, 0); } while (0)
#define PG8_LDA(dst, b, h) do { _Pragma("unroll") for (int m = 0; m < 4; ++m) _Pragma("unroll") for (int k = 0; k < 2; ++k) dst[m][k] = *(const PG8_LAS bf16x8*)(lds + PG8_SA(b, h) + aoff + m * 2048 + k * 1024); } while (0)
#define PG8_LDB(dst, b, h) do { _Pragma("unroll") for (int n = 0; n < 2; ++n) _Pragma("unroll") for (int k = 0; k < 2; ++k) dst[n][k] = *(const PG8_LAS bf16x8*)(lds + PG8_SB(b, h) + boff + n * 2048 + k * 1024); } while (0)
#define PG8_MMA(ai, bj, At, Bt) do { __builtin_amdgcn_s_setprio(1); _Pragma("unroll") for (int m = 0; m < 4; ++m) _Pragma("unroll") for (int n = 0; n < 2; ++n) _Pragma("unroll") for (int k = 0; k < 2; ++k) \
        acc[ai][bj][m][n] = __builtin_amdgcn_mfma_f32_16x16x32_bf16(Bt[n][k], At[m][k], acc[ai][bj][m][n], 0, 0, 0); __builtin_amdgcn_s_setprio(0); } while (0)
#define PG8_WAIT_V(n) asm volatile("s_waitcnt vmcnt(" #n ")" ::: "memory")
#define PG8_WAIT_L(n) asm volatile("s_waitcnt lgkmcnt(" #n ")" ::: "memory")
#define PG8_BAR __builtin_amdgcn_s_barrier()
#define PG8_SCHED __builtin_amdgcn_sched_barrier(0)
    Unit cur, nxt; int ui = 0;
    if (!S.next(0, cur)) return;
    f32x4 acc[2][2][4][2];
#pragma unroll
    for (int a = 0; a < 2; ++a)
#pragma unroll
        for (int b = 0; b < 2; ++b)
#pragma unroll
            for (int m = 0; m < 4; ++m)
#pragma unroll
                for (int n = 0; n < 2; ++n) acc[a][b][m][n] = (f32x4){0.f, 0.f, 0.f, 0.f};
    bf16x8 At[4][2], B0[2][2], B1[2][2];
    const char* cA = (const char*)g.A + (size_t)cur.pm * tstep; const char* cB = (const char*)g.Bt + (size_t)cur.pn * tstep;
    S.a_ready(cur);
    if constexpr (SP2) {
        PG8_STAGE(PG8_SB(0, 0), cB, voffB); PG8_STAGE(PG8_SB(0, 1), cB + hstep, voffB); PG8_STAGE(PG8_SA(0, 0), cA, voffA); PG8_STAGE(PG8_SA(0, 1), cA + hstep, voffA);
        if (wr == 1) PG8_BAR;
        PG8_WAIT_V(2); PG8_BAR;
        PG8_STAGE(PG8_SB(1, 0), cB + kstep, voffB); PG8_STAGE(PG8_SA(1, 0), cA + kstep, voffA); PG8_STAGE(PG8_SB(1, 1), cB + hstep + kstep, voffB);
        PG8_WAIT_V(6); PG8_BAR;
    } else {
        PG8_STAGE(PG8_SB(0, 0), cB, voffB); PG8_STAGE(PG8_SA(0, 0), cA, voffA); PG8_STAGE(PG8_SB(0, 1), cB + hstep, voffB); PG8_STAGE(PG8_SA(0, 1), cA + hstep, voffA);
        if (wr == 1) PG8_BAR;
        PG8_WAIT_V(4); PG8_BAR;
        PG8_STAGE(PG8_SB(1, 0), cB + kstep, voffB); PG8_STAGE(PG8_SA(1, 0), cA + kstep, voffA); PG8_STAGE(PG8_SB(1, 1), cB + hstep + kstep, voffB);
        PG8_WAIT_V(6); PG8_BAR;
    }
    for (;;) {
        const bool has_next = S.next(ui + 1, nxt);
        const char* nA = has_next ? (const char*)g.A + (size_t)nxt.pm * tstep : cA; const char* nB = has_next ? (const char*)g.Bt + (size_t)nxt.pn * tstep : cB;
        for (int t = 0; t < nt; t += 2) {
            const bool last = (t == nt - 2);
            const char* a1 = cA + (size_t)(t + 1) * kstep;
            const char* a2 = last ? nA : cA + (size_t)(t + 2) * kstep; const char* b2 = last ? nB : cB + (size_t)(t + 2) * kstep;
            const char* a3 = a2 + kstep; const char* b3 = b2 + kstep;
            if (last && has_next) S.a_ready(nxt);
            if constexpr (SP2) {
            PG8_LDB(B0, 0, 0); PG8_LDB(B1, 0, 1); PG8_SCHED; PG8_LDA(At, 0, 0); PG8_STAGE(PG8_SA(1, 1), a1 + hstep, voffA);
            PG8_WAIT_V(8); PG8_WAIT_L(0); PG8_BAR; PG8_MMA(0, 0, At, B0); PG8_MMA(0, 1, At, B1); PG8_BAR; PG8_SCHED;
            PG8_LDA(At, 0, 1); PG8_STAGE(PG8_SB(0, 0), b2, voffB); PG8_STAGE(PG8_SB(0, 1), b2 + hstep, voffB); PG8_STAGE(PG8_SA(0, 0), a2, voffA);
            PG8_WAIT_V(8); PG8_WAIT_L(0); PG8_BAR; PG8_MMA(1, 0, At, B0); PG8_MMA(1, 1, At, B1); PG8_BAR; PG8_SCHED;
            PG8_LDB(B0, 1, 0); PG8_LDB(B1, 1, 1); PG8_SCHED; PG8_LDA(At, 1, 0); PG8_STAGE(PG8_SA(0, 1), a2 + hstep, voffA);
            PG8_WAIT_V(8); PG8_WAIT_L(0); PG8_BAR; PG8_MMA(0, 0, At, B0); PG8_MMA(0, 1, At, B1); PG8_BAR; PG8_SCHED;
            PG8_LDA(At, 1, 1); PG8_STAGE(PG8_SB(1, 0), b3, voffB); PG8_STAGE(PG8_SB(1, 1), b3 + hstep, voffB); PG8_STAGE(PG8_SA(1, 0), a3, voffA);
            PG8_WAIT_V(8); PG8_WAIT_L(0); PG8_BAR; PG8_MMA(1, 0, At, B0); PG8_MMA(1, 1, At, B1); PG8_BAR; PG8_SCHED;
            } else {
            PG8_LDB(B0, 0, 0); PG8_SCHED; PG8_LDA(At, 0, 0); PG8_STAGE(PG8_SA(1, 1), a1 + hstep, voffA);
            PG8_WAIT_L(8); PG8_BAR; PG8_WAIT_L(0); PG8_MMA(0, 0, At, B0); PG8_BAR; PG8_SCHED;
            PG8_LDB(B1, 0, 1); PG8_STAGE(PG8_SB(0, 0), b2, voffB);
            PG8_BAR; PG8_WAIT_L(0); PG8_MMA(0, 1, At, B1); PG8_BAR;
            PG8_LDA(At, 0, 1); PG8_STAGE(PG8_SA(0, 0), a2, voffA);
            PG8_BAR; PG8_WAIT_L(0); PG8_MMA(1, 0, At, B0); PG8_BAR; PG8_SCHED;
            PG8_STAGE(PG8_SB(0, 1), b2 + hstep, voffB);
            PG8_WAIT_V(6); PG8_BAR; PG8_MMA(1, 1, At, B1); PG8_BAR;
            PG8_LDB(B0, 1, 0); PG8_SCHED; PG8_LDA(At, 1, 0); PG8_STAGE(PG8_SA(0, 1), a2 + hstep, voffA);
            PG8_WAIT_L(8); PG8_BAR; PG8_WAIT_L(0); PG8_MMA(0, 0, At, B0); PG8_BAR; PG8_SCHED;
            PG8_LDB(B1, 1, 1); PG8_STAGE(PG8_SB(1, 0), b3, voffB);
            PG8_BAR; PG8_WAIT_L(0); PG8_MMA(0, 1, At, B1); PG8_BAR;
            PG8_LDA(At, 1, 1); PG8_STAGE(PG8_SA(1, 0), a3, voffA);
            PG8_BAR; PG8_WAIT_L(0); PG8_MMA(1, 0, At, B0); PG8_BAR; PG8_SCHED;
            PG8_STAGE(PG8_SB(1, 1), b3 + hstep, voffB);
            PG8_WAIT_V(6); PG8_BAR; PG8_MMA(1, 1, At, B1); PG8_BAR;
            }
        }
        if constexpr (ALIGN_EPI) { if (wr == 0) PG8_BAR; }
        if constexpr (!Epi::AFTER_DRAIN) { E(acc, cur, wr, wc, fr, fq); S.done(cur); }
        if (!has_next) break;
#pragma unroll
        for (int a = 0; a < 2; ++a)
#pragma unroll
            for (int b = 0; b < 2; ++b)
#pragma unroll
                for (int m = 0; m < 4; ++m)
#pragma unroll
                    for (int n = 0; n < 2; ++n) acc[a][b][m][n] = (f32x4){0.f, 0.f, 0.f, 0.f};
        cur = nxt; cA = nA; cB = nB; ++ui;
        if constexpr (ALIGN_EPI) { if (wr == 1) PG8_BAR; }
    }
    PG8_WAIT_V(0);
    if constexpr (!ALIGN_EPI) { if (wr == 0) PG8_BAR; }
    PG8_BAR;
    if constexpr (Epi::AFTER_DRAIN) { E.fused(acc, cur, wr, wc, fr, fq, lds, wid, lane); S.done(cur); }
#undef PG8_SA
#undef PG8_SB
#undef PG8_STAGE
#undef PG8_LDA
#undef PG8_LDB
#undef PG8_MMA
#undef PG8_WAIT_V
#undef PG8_WAIT_L
#undef PG8_BAR
#undef PG8_SCHED
}
}

#ifndef PG8_SP2
#define PG8_SP2 true
#endif
#ifndef PG8_ALIGN
#define PG8_ALIGN true
#endif
#include <hip/hip_bf16.h>
#include <cmath>
namespace attn_body {
using bf16=__hip_bfloat16;
using bf16x8=__attribute__((ext_vector_type(8)))short;
using s16x4=__attribute__((ext_vector_type(4)))short;
using f32x16=__attribute__((ext_vector_type(16)))float;
using u32x4=__attribute__((ext_vector_type(4)))unsigned;
constexpr int BATCH=1,NHEAD=32,SEQ=16384,D=64,DM=NHEAD*D;
constexpr int NW=8,QBLK=32,QB=QBLK*NW,KVBLK=64,NQB=SEQ/QB;
constexpr int ATTN_PITCH=DM, ATTN_UNIT_ROWS=QB;
__device__ __forceinline__ int crow(int r,int hi){return (r&3)+8*(r>>2)+4*hi;}
#define SBAR() __builtin_amdgcn_sched_barrier(0)
__device__ __forceinline__ void cmask(f32x16&p0,f32x16&p1,int jb,int qrel,int hi){
  const float NEG=-INFINITY; int kb=64*jb+4*hi;
  #pragma unroll
  for(int r=0;r<16;++r){int kv=kb+(r&3)+8*(r>>2); if(kv>qrel)p0[r]=NEG; if(kv+32>qrel)p1[r]=NEG;}
}

constexpr int NSLOT=3, SLOTB=8192;
constexpr int LDS_K=0, LDS_V=NSLOT*SLOTB, LDS_WS=2*NSLOT*SLOTB, LDS_OST=LDS_WS+NW*64*4, LDS_BYTES=LDS_OST+NW*4096;
constexpr float C2=0.125f*1.4426950408889634f;
__device__ __forceinline__ void glds16(const void*gsrc,unsigned lds_dst){unsigned keep;
  asm volatile("s_mov_b32 %0, m0\n\ts_mov_b32 m0, %2\n\ts_nop 0\n\tglobal_load_lds_dwordx4 %1, off\n\ts_mov_b32 m0, %0":"=&s"(keep):"v"(gsrc),"s"(lds_dst):"memory");}
__device__ __forceinline__ float max3f(float a,float b,float c){float r;asm("v_max3_f32 %0, %1, %2, %3":"=v"(r):"v"(a),"v"(b),"v"(c));return r;}
__device__ __forceinline__ float max2f(float a,float b){float r;asm("v_max_f32_e32 %0, %1, %2":"=v"(r):"v"(a),"v"(b));return r;}
__device__ __forceinline__ float fadd_s(float a,float b){float r;asm("v_add_f32_e32 %0, %1, %2":"=v"(r):"v"(a),"v"(b));return r;}
__device__ __forceinline__ float fsub_s(float a,float b){float r;asm("v_sub_f32_e32 %0, %1, %2":"=v"(r):"v"(a),"v"(b));return r;}
typedef float f32x2_t __attribute__((ext_vector_type(2))); typedef __bf16 bf16x2_t __attribute__((ext_vector_type(2)));
__device__ __forceinline__ unsigned cvtpk_s(float lo,float hi){f32x2_t v={lo,hi};bf16x2_t b=__builtin_convertvector(v,bf16x2_t);return __builtin_bit_cast(unsigned,b);}
#define WAIT_BAR(N) asm volatile("s_waitcnt vmcnt(" #N ") lgkmcnt(0)\n\ts_barrier":::"memory")

__device__ __forceinline__ void qkt(f32x16&p0,f32x16&p1,const char*Kslot,const bf16x8*qr,const f32x16&negm,int r32,int hi){
  const char*kb=Kslot+hi*1024+r32*16;
  #pragma unroll
  for(int d0=0;d0<4;++d0){
    const bf16x8 b0=*reinterpret_cast<const bf16x8*>(kb+d0*2048);
    const bf16x8 b1=*reinterpret_cast<const bf16x8*>(kb+d0*2048+512);
    if(d0==0){p0=__builtin_amdgcn_mfma_f32_32x32x16_bf16(b0,qr[0],negm,0,0,0);p1=__builtin_amdgcn_mfma_f32_32x32x16_bf16(b1,qr[0],negm,0,0,0);}
    else{p0=__builtin_amdgcn_mfma_f32_32x32x16_bf16(b0,qr[d0],p0,0,0,0);p1=__builtin_amdgcn_mfma_f32_32x32x16_bf16(b1,qr[d0],p1,0,0,0);}}
}
typedef __attribute__((address_space(3))) const char* lds_cptr;
typedef short v4i16_t __attribute__((ext_vector_type(4)));
__device__ __forceinline__ void kload8(bf16x8*kf,lds_cptr kp){
  kf[0]=*(const __attribute__((address_space(3))) bf16x8*)(kp);      kf[1]=*(const __attribute__((address_space(3))) bf16x8*)(kp+512);
  kf[2]=*(const __attribute__((address_space(3))) bf16x8*)(kp+2048); kf[3]=*(const __attribute__((address_space(3))) bf16x8*)(kp+2560);
  kf[4]=*(const __attribute__((address_space(3))) bf16x8*)(kp+4096); kf[5]=*(const __attribute__((address_space(3))) bf16x8*)(kp+4608);
  kf[6]=*(const __attribute__((address_space(3))) bf16x8*)(kp+6144); kf[7]=*(const __attribute__((address_space(3))) bf16x8*)(kp+6656);
}
__device__ __forceinline__ void kload2(bf16x8*kf,lds_cptr kp,int j){ kf[2*j]=*(const __attribute__((address_space(3))) bf16x8*)(kp+j*2048); kf[2*j+1]=*(const __attribute__((address_space(3))) bf16x8*)(kp+j*2048+512); }
__device__ __forceinline__ s16x4 vtr(lds_cptr p){ return __builtin_bit_cast(s16x4,__builtin_amdgcn_ds_read_tr16_b64_v4i16((__attribute__((address_space(3))) v4i16_t*)p)); }
__device__ __forceinline__ float rowmax(const f32x16&p0,const f32x16&p1){
  float a=max3f(p0[0],p0[1],p1[0]),b=max3f(p0[2],p0[3],p1[1]);a=max3f(a,p1[2],p1[3]);
  #pragma unroll
  for(int r=4;r<16;r+=4){a=max3f(a,p0[r],p0[r+1]);b=max3f(b,p0[r+2],p0[r+3]);a=max3f(a,p1[r],p1[r+1]);b=max3f(b,p1[r+2],p1[r+3]);}
  const float m=max2f(a,b);
  auto rr=__builtin_amdgcn_permlane32_swap(__float_as_uint(m),__float_as_uint(m),false,false);
  return max2f(__uint_as_float(rr[0]),__uint_as_float(rr[1]));
}
__device__ __forceinline__ void pv(f32x16*o,int vb,bf16x8 pa0,bf16x8 pa1,bf16x8 pa2,bf16x8 pa3){
  #pragma unroll
  for(int d0=0;d0<2;++d0){s16x4 lo[4],hi[4];
    #pragma unroll
    for(int ks=0;ks<4;++ks){
      asm volatile("ds_read_b64_tr_b16 %0,%1 offset:%c2":"=&v"(lo[ks]):"v"(vb),"i"(d0*4096+ks*1024):"memory");
      asm volatile("ds_read_b64_tr_b16 %0,%1 offset:%c2":"=&v"(hi[ks]):"v"(vb),"i"(d0*4096+ks*1024+512):"memory");}
    asm volatile("s_waitcnt lgkmcnt(0)":::"memory");SBAR();
    #define PK(k) (bf16x8){lo[k][0],lo[k][1],lo[k][2],lo[k][3],hi[k][0],hi[k][1],hi[k][2],hi[k][3]}
    o[d0]=__builtin_amdgcn_mfma_f32_32x32x16_bf16(pa0,PK(0),o[d0],0,0,0);
    o[d0]=__builtin_amdgcn_mfma_f32_32x32x16_bf16(pa1,PK(1),o[d0],0,0,0);
    o[d0]=__builtin_amdgcn_mfma_f32_32x32x16_bf16(pa2,PK(2),o[d0],0,0,0);
    o[d0]=__builtin_amdgcn_mfma_f32_32x32x16_bf16(pa3,PK(3),o[d0],0,0,0);
    #undef PK
  }
}

#ifndef ATTN_STORE16
#define ATTN_STORE16(p,v) (*(u32x4*)(p)=(v))
#endif
template<int THRL> __device__ __forceinline__ void attn_unit(int qh,int vh,int qb,const bf16*Q,const bf16*__restrict__ K,const bf16*__restrict__ V,bf16*O,char*shm){
  int tid_=threadIdx.x; asm volatile("":"+v"(tid_));
  const int tid=tid_,lane=tid&63,r32=lane&31,hi=lane>>5; const int wid=__builtin_amdgcn_readfirstlane(tid>>6);
  const long rowbase=0; const int q0=qb*QB;
  const bf16*Qw=Q+(rowbase+q0+wid*QBLK)*DM+qh*D;
  const bf16*Kh=K+rowbase*DM+qh*D,*Vh=V+rowbase*DM+vh*D;
  const unsigned lds0=(unsigned)(uintptr_t)shm;
  float*wsf=(float*)(shm+LDS_WS)+wid*64;
  const bf16*ksrc=Kh+(long)lane*DM+wid*8;
  const bf16*vsrc=Vh+(long)(16*(wid&3)+(lane>>2))*DM+(wid>>2)*32+(lane&3)*8;
  const unsigned kdst=lds0+LDS_K+wid*1024, vdst=lds0+LDS_V+wid*1024;
  #define DMA_K(t,slot) glds16(ksrc+(long)(t)*KVBLK*DM,(unsigned)__builtin_amdgcn_readfirstlane(kdst+(slot)))
  #define DMA_V(t,slot) glds16(vsrc+(long)(t)*KVBLK*DM,(unsigned)__builtin_amdgcn_readfirstlane(vdst+(slot)))
  const int vb0=(int)(lds0+LDS_V)+((lane>>4)&1)*32+(lane&3)*8+(4*hi+((lane&15)>>2))*64;
  const char*Kbase=shm+LDS_K; bf16x8 kf[8];
  const lds_cptr shm3=(lds_cptr)shm; const lds_cptr kp0=shm3+LDS_K+hi*1024+r32*16; const lds_cptr vp0=shm3+LDS_V+((lane>>4)&1)*32+(lane&3)*8+(4*hi+((lane&15)>>2))*64;
  const int NT=(q0+QB)/KVBLK;
  DMA_K(0,0);DMA_V(0,0);DMA_K(1,SLOTB);
  bf16x8 qr[4];
  #pragma unroll
  for(int d0=0;d0<4;++d0)qr[d0]=*reinterpret_cast<const bf16x8*>(&Qw[(long)r32*DM+d0*16+hi*8]);
  float mhat=0.f,l_reg=0.f;f32x16 o[2];o[0]=f32x16{};o[1]=f32x16{};f32x16 negm=f32x16{};asm volatile("":"+v"(negm));
  const int qrel=wid*QBLK+r32;
  #define CMASK(P0,P1,t) do{int jb_=(t)-(NT-4); if(jb_>=0)cmask(P0,P1,jb_,qrel,hi);}while(0)
  bool resc=false;
  #define START(P0,P1) do{ const float rm=rowmax(P0,P1); resc=false; \
    { const float dl=rm; mhat=fadd_s(mhat,dl); \
      _Pragma("unroll") for(int r=0;r<16;++r){P0[r]=fsub_s(P0[r],dl);P1[r]=fsub_s(P1[r],dl);} \
      _Pragma("unroll") for(int r=0;r<16;++r)negm[r]=-mhat; asm volatile("":"+v"(negm)); } \
    _Pragma("unroll") for(int r=0;r<16;++r)P0[r]=__builtin_amdgcn_exp2f(P0[r]); }while(0)
  #define RESC() do{ if(resc){ asm volatile("s_waitcnt lgkmcnt(0)":::"memory"); \
      _Pragma("unroll") for(int d_=0;d_<2;++d_) _Pragma("unroll") for(int r=0;r<16;++r)o[d_][r]*=wsf[crow(r,hi)]; } }while(0)
  f32x16 pA0,pA1,pB0,pB1;
  int sl_prev=0,sl_cur=0,sl_next=SLOTB;
  #define ROT() do{sl_prev=sl_cur;sl_cur=sl_next;sl_next=(sl_next==(NSLOT-1)*SLOTB)?0:sl_next+SLOTB;}while(0)
  DMA_K(2,2*SLOTB);
  WAIT_BAR(3);
  qkt(pA0,pA1,Kbase,qr,negm,r32,hi);asm volatile("s_nop 15\n\ts_nop 7":"+v"(pA0),"+v"(pA1));CMASK(pA0,pA1,0);
  START(pA0,pA1);
  _Pragma("unroll") for(int r=0;r<16;++r)pA1[r]=__builtin_amdgcn_exp2f(pA1[r]);
  WAIT_BAR(0);
  DMA_K(3,0);DMA_V(1,SLOTB);
  ROT();
  kload8(kf,kp0+sl_cur);
  WAIT_BAR(2);
  s16x4 vlo[8],vhi[8]; u32x4 pw0,pw1,pw2,pw3;
  #define PKW(P,B) cvtpk_s(P[B],P[B+1])
  #define PAF(k) __builtin_bit_cast(bf16x8,pw##k)
  #define VFR(i) (bf16x8){vlo[i][0],vlo[i][1],vlo[i][2],vlo[i][3],vhi[i][0],vhi[i][1],vhi[i][2],vhi[i][3]}
  #define PIN(x) asm volatile("":"+v"(x))
  #define MX3(a,b,c) __builtin_fmaxf(__builtin_fmaxf((a),(b)),(c))
  #define GAPA(MF,A0,A1,A2,A3,W0,W1,PW) do{ MF; sacc+=A0; sacc+=A1; sacc+=A2; sacc+=A3; PIN(sacc); W0; W1; PIN(PW); SBAR(); }while(0)
  #define EX(v) __builtin_amdgcn_exp2f(v)
  #define GAPB(MF,X,B) do{ MF; X[B]=EX(X[B]); X[B+1]=EX(X[B+1]); X[B+2]=EX(X[B+2]); X[B+3]=EX(X[B+3]); PIN(X); SBAR(); }while(0)
  #define VRD(i) do{ vlo[i]=vtr(vp_+(((i)>>2)*4096+((i)&3)*1024)); vhi[i]=vtr(vp_+(((i)>>2)*4096+((i)&3)*1024+512)); }while(0)
  #define KRD(G,j) do{ if(G){ kload2(kf,kp0+sl_next,j); SBAR(); } }while(0)
  #define STEP(C0,C1,P0,P1,t,GK,GV,GL) do{ SBAR(); \
    const lds_cptr vp_=vp0+sl_prev; \
    VRD(0); SBAR(); float sacc=(P0[0]+P0[1]); \
    GAPA(C0=__builtin_amdgcn_mfma_f32_32x32x16_bf16(kf[0],qr[0],negm,0,0,0), P0[2],P0[3],P0[4],P0[5],     pw0[0]=PKW(P0,0), pw0[1]=PKW(P0,2), pw0); \
    VRD(4); SBAR(); GAPA(C1=__builtin_amdgcn_mfma_f32_32x32x16_bf16(kf[1],qr[0],negm,0,0,0), P0[6],P0[7],P0[8],P0[9],     pw0[2]=PKW(P0,4), pw0[3]=PKW(P0,6), pw0); \
    VRD(1); SBAR(); GAPA(C0=__builtin_amdgcn_mfma_f32_32x32x16_bf16(kf[2],qr[1],C0,0,0,0),   P0[10],P0[11],P0[12],P0[13], pw1[0]=PKW(P0,8), pw1[1]=PKW(P0,10), pw1); \
    VRD(5); SBAR(); GAPA(C1=__builtin_amdgcn_mfma_f32_32x32x16_bf16(kf[3],qr[1],C1,0,0,0),   P0[14],P0[15],P1[0],P1[1],   pw1[2]=PKW(P0,12),pw1[3]=PKW(P0,14), pw1); \
    VRD(2); SBAR(); GAPA(C0=__builtin_amdgcn_mfma_f32_32x32x16_bf16(kf[4],qr[2],C0,0,0,0),   P1[2],P1[3],P1[4],P1[5],     pw2[0]=PKW(P1,0), pw2[1]=PKW(P1,2), pw2); \
    VRD(6); SBAR(); GAPA(C1=__builtin_amdgcn_mfma_f32_32x32x16_bf16(kf[5],qr[2],C1,0,0,0),   P1[6],P1[7],P1[8],P1[9],     pw2[2]=PKW(P1,4), pw2[3]=PKW(P1,6), pw2); \
    VRD(3); SBAR(); GAPA(C0=__builtin_amdgcn_mfma_f32_32x32x16_bf16(kf[6],qr[3],C0,0,0,0),   P1[10],P1[11],P1[12],P1[13], pw3[0]=PKW(P1,8), pw3[1]=PKW(P1,10), pw3); \
    VRD(7); SBAR(); GAPA(C1=__builtin_amdgcn_mfma_f32_32x32x16_bf16(kf[7],qr[3],C1,0,0,0),   P1[14],P1[15],0.f,0.f,       pw3[2]=PKW(P1,12),pw3[3]=PKW(P1,14), pw3); \
    l_reg+=sacc; \
    if(GK){DMA_K((t)+3,sl_cur);} if(GV){DMA_V((t)+1,sl_next);} \
    CMASK(C0,C1,t); \
    { float a=MX3(C0[0],C0[1],C1[0]),b=MX3(C0[2],C0[3],C1[1]); a=MX3(a,C1[2],C1[3]); \
      _Pragma("unroll") for(int r=4;r<16;r+=4){a=MX3(a,C0[r],C0[r+1]);b=MX3(b,C0[r+2],C0[r+3]);a=MX3(a,C1[r],C1[r+1]);b=MX3(b,C1[r+2],C1[r+3]);} \
      float rm=__builtin_fmaxf(a,b); { auto rr=__builtin_amdgcn_permlane32_swap(__float_as_uint(rm),__float_as_uint(rm),false,false); rm=__builtin_fmaxf(__uint_as_float(rr[0]),__uint_as_float(rr[1])); } \
      resc=false; \
      if(__builtin_expect(__any(rm>(float)THRL),0)){ const float dl=__builtin_fmaxf(rm,0.f); mhat+=dl; \
        _Pragma("unroll") for(int r=0;r<16;++r){C0[r]-=dl;C1[r]-=dl;} \
        _Pragma("unroll") for(int r=0;r<16;++r)negm[r]=-mhat; asm volatile("":"+v"(negm)); \
        const float f=__builtin_amdgcn_exp2f(-dl); l_reg*=f; if(hi==0)wsf[r32]=f; resc=true; } } \
    SBAR(); \
    GAPB(o[0]=__builtin_amdgcn_mfma_f32_32x32x16_bf16(PAF(0),VFR(0),o[0],0,0,0), C0,0); \
    GAPB(o[1]=__builtin_amdgcn_mfma_f32_32x32x16_bf16(PAF(0),VFR(4),o[1],0,0,0), C0,4); \
    KRD(GL,0); GAPB(o[0]=__builtin_amdgcn_mfma_f32_32x32x16_bf16(PAF(1),VFR(1),o[0],0,0,0), C0,8); \
    KRD(GL,1); GAPB(o[1]=__builtin_amdgcn_mfma_f32_32x32x16_bf16(PAF(1),VFR(5),o[1],0,0,0), C0,12); \
    KRD(GL,2); GAPB(o[0]=__builtin_amdgcn_mfma_f32_32x32x16_bf16(PAF(2),VFR(2),o[0],0,0,0), C1,0); \
    KRD(GL,3); GAPB(o[1]=__builtin_amdgcn_mfma_f32_32x32x16_bf16(PAF(2),VFR(6),o[1],0,0,0), C1,4); \
    GAPB(o[0]=__builtin_amdgcn_mfma_f32_32x32x16_bf16(PAF(3),VFR(3),o[0],0,0,0), C1,8); \
    GAPB(o[1]=__builtin_amdgcn_mfma_f32_32x32x16_bf16(PAF(3),VFR(7),o[1],0,0,0), C1,12); \
    }while(0)
  int t=1;
  #undef CMASK
  #define CMASK(P0,P1,t) do{}while(0)
  for(;t+5<NT;t+=2){
    STEP(pB0,pB1,pA0,pA1,t,true,true,true);     WAIT_BAR(2); RESC(); ROT();
    STEP(pA0,pA1,pB0,pB1,t+1,true,true,true);   WAIT_BAR(2); RESC(); ROT();
  }
  #undef CMASK
  #define CMASK(P0,P1,t) do{int jb_=(t)-(NT-4); if(jb_>=0)cmask(P0,P1,jb_,qrel,hi);}while(0)
  #define ENDW(tt) do{ if((tt)+3<NT){WAIT_BAR(2);} else if((tt)+2<NT){WAIT_BAR(1);} else {WAIT_BAR(0);} }while(0)
  for(;t+1<NT;t+=2){
    STEP(pB0,pB1,pA0,pA1,t,(t+3<NT),(t+1<NT),(t+1<NT));       ENDW(t);   RESC(); ROT();
    STEP(pA0,pA1,pB0,pB1,t+1,(t+4<NT),(t+2<NT),(t+2<NT));     ENDW(t+1); RESC(); ROT();
  }
  STEP(pB0,pB1,pA0,pA1,NT-1,false,false,false); RESC();
  { float sacc=pB0[0]+pB0[1]; _Pragma("unroll") for(int r=2;r<16;++r)sacc+=pB0[r]; _Pragma("unroll") for(int r=0;r<16;++r)sacc+=pB1[r]; l_reg+=sacc;
    pw0=(u32x4){PKW(pB0,0),PKW(pB0,2),PKW(pB0,4),PKW(pB0,6)};pw1=(u32x4){PKW(pB0,8),PKW(pB0,10),PKW(pB0,12),PKW(pB0,14)};pw2=(u32x4){PKW(pB1,0),PKW(pB1,2),PKW(pB1,4),PKW(pB1,6)};pw3=(u32x4){PKW(pB1,8),PKW(pB1,10),PKW(pB1,12),PKW(pB1,14)};
    SBAR(); pv(o,vb0+sl_cur,PAF(0),PAF(1),PAF(2),PAF(3)); }
  #undef PKW
  #undef PAF
  #undef VFR
  #undef PIN
  #undef MX3
  #undef GAPA
  #undef GAPB
  #undef EX
  #undef VRD
  #undef KRD
  #undef STEP
  #undef ENDW
  {auto rr=__builtin_amdgcn_permlane32_swap(__float_as_uint(l_reg),__float_as_uint(l_reg),false,false);l_reg=__uint_as_float(rr[0])+__uint_as_float(rr[1]);}
  if(hi==0)wsf[32+r32]=l_reg;asm volatile("s_waitcnt lgkmcnt(0)":::"memory");
  float rli[16];
  #pragma unroll
  for(int r=0;r<16;++r)rli[r]=__builtin_amdgcn_rcpf(wsf[32+crow(r,hi)]);
  bf16*Ow=O+(rowbase+q0+wid*QBLK)*DM+vh*D;
  { bf16*stg=(bf16*)(shm+LDS_OST)+wid*2048;
    #pragma unroll
    for(int r=0;r<16;++r){const int orow=crow(r,hi);
      #pragma unroll
      for(int d0=0;d0<2;++d0)stg[orow*64+d0*32+r32]=__float2bfloat16(o[d0][r]*rli[r]);}
    asm volatile("s_waitcnt lgkmcnt(0)":::"memory");
    #pragma unroll
    for(int i=0;i<4;++i){const int row=i*8+(lane>>3),ch=lane&7; const u32x4 v=*(const u32x4*)(stg+row*64+ch*8); ATTN_STORE16(Ow+(long)row*DM+ch*8,v);} }
  asm volatile("s_waitcnt lgkmcnt(0)\n\ts_barrier":::"memory");
  #undef DMA_K
  #undef DMA_V
  #undef CMASK
  #undef START
  #undef RESC
  #undef ROT
}
constexpr int ATTN_LDS_BYTES=LDS_BYTES;
struct AttnTensors { const bf16* Q; const bf16* K; const bf16* V; bf16* O0; bf16* O1; };
struct AttnUnit { int vv; int qb; };
struct StaticOrder {
  int x, j;
  __device__ __forceinline__ explicit StaticOrder(int vcu):x(vcu>>5),j(vcu&31){}
  __device__ __forceinline__ bool next(int i,AttnUnit&u)const{ if(i>=16)return false; u.vv=x*8+(i>>1); u.qb=(i&1)?63-j:j; return true; }
  __device__ __forceinline__ void a_ready(const AttnUnit&)const{}
  __device__ __forceinline__ void done(const AttnUnit&)const{}
};
template<class Sched,int THRL=8> __device__ __forceinline__ void attn_phase(char*lds,const AttnTensors&T,const Sched&S){
  AttnUnit u;
  for(int i=0;S.next(i,u);++i){ S.a_ready(u); const int h=u.vv>>2,c=(u.vv>>1)&1,jv=u.vv&1; attn_unit<THRL>(2*h+c,2*h+jv,u.qb,T.Q,T.K,T.V,c?T.O1:T.O0,lds); S.done(u); }
}
#undef SBAR
#undef WAIT_BAR
}
constexpr int NWAVES = 8;
#ifndef EN_MASK
#define EN_MASK 0xffff
#endif
#define EN(k) ((EN_MASK >> (k)) & 1)
#ifndef MK_SPLIT
#define MK_SPLIT 1
#endif
constexpr int T = 16384, D = 2048, FF = 5632, DEPTH = 4, M = T;
constexpr int PH_PER_LAYER = 11, N_PHASES = DEPTH * PH_PER_LAYER;
constexpr float NORM_EPS = 1e-6f;

constexpr size_t MiB = 1u << 20;
constexpr size_t WS_CTL = 0, CTL_ZERO_BYTES = 1 * MiB;
constexpr size_t WS_SMALL = 1 * MiB;
constexpr size_t WS_ROPE = 2 * MiB;
constexpr size_t WS_RTAB = 4 * MiB;
constexpr size_t WS_W1GU = 32 * MiB, WS_W1D = 76 * MiB, WS_W2GU = 98 * MiB, WS_W2D = 142 * MiB, WS_WMIX = 164 * MiB;
constexpr size_t WS_XN = 228 * MiB;
constexpr size_t WS_ACT = 292 * MiB;
constexpr size_t WS_H = WS_ACT;
constexpr size_t WS_Q = WS_ACT, WS_K = WS_ACT + 64 * MiB, WS_V = WS_ACT + 128 * MiB, WS_O0 = WS_ACT + 192 * MiB, WS_O1 = WS_ACT + 256 * MiB, WS_ON = WS_ACT + 320 * MiB;
constexpr size_t WS_QR = WS_ACT, WS_KR = WS_ACT + 64 * MiB, WS_KZT = WS_ACT + 128 * MiB, WS_VT = WS_ACT + 192 * MiB, WS_GS = WS_ACT + 320 * MiB, WS_RT = WS_ACT + 448 * MiB;
constexpr size_t WS_END = WS_ACT + 704 * MiB;
static_assert(WS_W1GU + (size_t)2 * FF * D * 2 <= WS_W1D && WS_W1D + (size_t)D * FF * 2 <= WS_W2GU && WS_W2GU + (size_t)2 * FF * D * 2 <= WS_W2D && WS_W2D + (size_t)D * FF * 2 <= WS_WMIX && WS_WMIX + 64 * MiB <= WS_XN, "weight map");
static_assert(WS_XN + (size_t)T * D * 2 <= WS_ACT && WS_H + (size_t)T * FF * 2 <= WS_END && WS_RT + (size_t)128 * 8 * 512 * 256 * 2 <= WS_END && WS_VT + (size_t)4096 * T * 2 <= WS_GS && WS_GS + (size_t)T * 4096 * 2 <= WS_RT, "activation map");
constexpr int CW_TMO = 0, CW_CODE = 1;
constexpr int CW_BAR = 4096;

constexpr int RING_OFF = 0, RING_BYTES = 131072;
constexpr int LDSCTL_OFF = RING_BYTES, MISC_OFF = LDSCTL_OFF + 320, PTAB_OFF = LDSCTL_OFF + 1024;
constexpr int LDS_BYTES = 147456;
static_assert(MISC_OFF + 128 <= PTAB_OFF && PTAB_OFF + 28 * 8 <= LDS_BYTES, "LDS map");

#define GAS __attribute__((address_space(1)))
#define LAS __attribute__((address_space(3)))
typedef unsigned short bf16;
typedef unsigned v4u __attribute__((ext_vector_type(4)));
typedef float f32x4 __attribute__((ext_vector_type(4)));
typedef short bf16x8 __attribute__((ext_vector_type(8)));
typedef GAS unsigned gu32;
typedef GAS unsigned long long gu64;
#define RLX_AGENT __ATOMIC_RELAXED, __HIP_MEMORY_SCOPE_AGENT
#define LDS_WAIT() asm volatile("s_waitcnt lgkmcnt(0)" ::: "memory")
#define VM_WAIT() asm volatile("s_waitcnt vmcnt(0)" ::: "memory")
__device__ __forceinline__ unsigned long long rt() { return __builtin_amdgcn_s_memrealtime(); }
__device__ __forceinline__ unsigned f2bf(float f) { unsigned u = __builtin_bit_cast(unsigned, f); return (u + 0x7fffu + ((u >> 16) & 1u)) >> 16; }
__device__ __forceinline__ unsigned pk2(float lo, float hi) { return f2bf(lo) | (f2bf(hi) << 16); }

#define XB_TMO      128
#define XB_XCNT(j)  (256  + 64 * (j))
#define XB_XSUB(j)  (1280 + 64 * (j))
#define XB_XGEN(j)  (2304 + 64 * (j))
#define XB_TOP      3328
#define XB_TOPGEN   3392
#define XCD_BAR_WORDS 3456
#define XB_SPIN_CAP (1u << 18)

__device__ __forceinline__ unsigned xb_ld(unsigned* p)              { return __hip_atomic_load(p, __ATOMIC_RELAXED, __HIP_MEMORY_SCOPE_AGENT); }
__device__ __forceinline__ unsigned xb_add(unsigned* p, unsigned v) { return __hip_atomic_fetch_add(p, v, __ATOMIC_RELAXED, __HIP_MEMORY_SCOPE_AGENT); }
__device__ __forceinline__ unsigned xb_xcc_id() { return (unsigned)__builtin_amdgcn_s_getreg((3 << 11) | 20) & 0xFu; }
#define XB_SPIN(cond, bar) do { unsigned _sp = 0; while (cond) { __builtin_amdgcn_s_sleep(1); \
    if ((++_sp & 255u) == 0u) { if (xb_ld(&(bar)[XB_TMO])) break; if (_sp > XB_SPIN_CAP) { atomicAdd(&(bar)[XB_TMO], 1u); break; } } } } while (0)

struct XcdBarrier {
    unsigned* bar; unsigned x;
    volatile LAS unsigned* st;
};

__device__ __forceinline__ XcdBarrier xcd_barrier_post(unsigned* bar, volatile LAS unsigned* st) {
    XcdBarrier b; b.bar = bar; b.x = xb_xcc_id(); b.st = st;
    if (threadIdx.x == 0) (void)xb_add(&bar[XB_XCNT(b.x)], 1u);
    return b;
}
__device__ __forceinline__ void xcd_barrier_complete(unsigned* bar, unsigned x, unsigned& nloc, unsigned& nx) {
    const unsigned G = gridDim.x * gridDim.y * gridDim.z;
    unsigned sum, cnt, mine, sp = 0u;
    for (;;) {
        sum = 0u; cnt = 0u; mine = 0u;
#pragma unroll
        for (unsigned j = 0; j < 16; ++j) { const unsigned c = xb_ld(&bar[XB_XCNT(j)]); sum += c; cnt += (c > 0u) ? 1u : 0u; mine = (j == x) ? c : mine; }
        if (sum == G) break;
        __builtin_amdgcn_s_sleep(1);
        if ((++sp & 255u) == 0u) { if (xb_ld(&bar[XB_TMO])) break; if (sp > XB_SPIN_CAP) { atomicAdd(&bar[XB_TMO], 1u); break; } }
    }
    nloc = mine > 0u ? mine : 1u; nx = cnt > 0u ? cnt : 1u;
}

__device__ __forceinline__ void xcd_barrier(const XcdBarrier& b) {
    asm volatile("s_waitcnt vmcnt(0)" ::: "memory");
    __syncthreads();
    if (threadIdx.x == 0) {
        unsigned* bar = b.bar;
        __builtin_amdgcn_s_waitcnt(0);
        unsigned nloc = b.st[0], nx = b.st[1];
        if (nloc == 0u) { xcd_barrier_complete(bar, b.x, nloc, nx); b.st[0] = nloc; b.st[1] = nx; }
        const unsigned old = xb_add(&bar[XB_XSUB(b.x)], 1u);
        const unsigned gen = old / nloc;
        if (old + 1u == (gen + 1u) * nloc) {
            __builtin_amdgcn_fence(__ATOMIC_RELEASE, "agent");
            asm volatile("s_waitcnt vmcnt(0)" ::: "memory");
            const unsigned og = xb_add(&bar[XB_TOP], 1u);
            const unsigned tg = og / nx;
            if (og + 1u == (tg + 1u) * nx) xb_add(&bar[XB_TOPGEN], 1u);
            else XB_SPIN(xb_ld(&bar[XB_TOPGEN]) == tg, bar);
            __builtin_amdgcn_fence(__ATOMIC_ACQUIRE, "agent");
            xb_add(&bar[XB_XGEN(b.x)], 1u);
            asm volatile("s_waitcnt vmcnt(0)" ::: "memory");
        } else {
            XB_SPIN(xb_ld(&bar[XB_XGEN(b.x)]) == gen, bar);
            __builtin_amdgcn_fence(__ATOMIC_ACQUIRE, "agent");
            asm volatile("s_waitcnt vmcnt(0)" ::: "memory");
        }
    }
    __syncthreads();
}

typedef float f32x2 __attribute__((ext_vector_type(2)));

struct Frame {
    LAS unsigned char* lds;
    volatile LAS unsigned* MISC;
    gu32* ctl;
    int tid, lane, wave;
    int vcu, G;
    unsigned char* ws;
};

__device__ __forceinline__ float wave_sum(float v) {
#pragma unroll
    for (int o = 1; o < 64; o <<= 1) v += __shfl_xor(v, o);
    return v;
}
__device__ __forceinline__ int conv_drow(int mode, int row_off, int n0) {
    if (mode == 0) return row_off + n0;
    if (mode == 1) return 256 * (n0 >> 7) + (n0 & 127);
    if (mode == 2) return 256 * (n0 >> 7) + 128 + (n0 & 127);
    const int cl = n0 & 255; return row_off + (n0 & ~255) + 128 * ((cl & 63) >> 5) + 32 * (cl >> 6);
}
__device__ __forceinline__ void conv_item(const float* W, int K, int N, bf16* WT, int mode, int row_off, LAS float* scr, int item, int lane) {
    const int nblk = N / 32, kb = item / nblk, nb = item % nblk, k0 = 64 * kb, n0 = 32 * nb;
    const int drow0 = conv_drow(mode, row_off, n0);
#pragma unroll 8
    for (int i = 0; i < 32; ++i) { const int kk = 2 * i + (lane >> 5); scr[kk * 33 + (lane & 31)] = W[(size_t)(k0 + kk) * N + n0 + (lane & 31)]; }
    LDS_WAIT(); asm volatile("" ::: "memory");
    const int c = lane & 7;
#pragma unroll
    for (int j = 0; j < 4; ++j) { const int n = (lane >> 3) + 8 * j; const LAS float* s = scr + (8 * c) * 33 + n;
        v4u o; o.x = pk2(s[0 * 33], s[1 * 33]); o.y = pk2(s[2 * 33], s[3 * 33]); o.z = pk2(s[4 * 33], s[5 * 33]); o.w = pk2(s[6 * 33], s[7 * 33]);
        *(GAS v4u*)(WT + (size_t)(drow0 + n) * K + k0 + 8 * c) = o; }
    LDS_WAIT(); asm volatile("" ::: "memory");
}
__device__ __forceinline__ int conv_matrix(Frame& F, const float* W, int K, int N, bf16* WT, int mode, int row_off, int prefix) {
    LAS float* scr = (LAS float*)(F.lds + RING_OFF + F.wave * 16384);
    const int NGW = F.G * NWAVES, gw = F.vcu * NWAVES + F.wave, nitems = (K / 64) * (N / 32);
    int start = (gw - prefix % NGW + NGW) % NGW;
    for (int it = start; it < nitems; it += NGW) conv_item(W, K, N, WT, mode, row_off, scr, it, F.lane);
    return prefix + nitems;
}
__device__ __forceinline__ void rmsnorm_phase(Frame& F, const float* x, const float* g, bf16* xn) {
    const int NGW = F.G * NWAVES, gw = F.vcu * NWAVES + F.wave;
    f32x4 gv[8];
#pragma unroll
    for (int j = 0; j < 8; ++j) gv[j] = ((const GAS f32x4*)g)[64 * j + F.lane];
    for (int m = gw; m < T; m += NGW) {
        const GAS f32x4* xr = (const GAS f32x4*)(x + (size_t)m * D) + F.lane;
        f32x4 v[8]; float s = 0.f;
#pragma unroll
        for (int j = 0; j < 8; ++j) { v[j] = xr[64 * j]; s += (v[j].x * v[j].x + v[j].y * v[j].y) + (v[j].z * v[j].z + v[j].w * v[j].w); }
        const float rs = 1.0f / sqrtf(wave_sum(s) * (1.0f / D) + NORM_EPS);
        GAS unsigned long long* o8 = (GAS unsigned long long*)(xn + (size_t)m * D) + F.lane;
#pragma unroll
        for (int j = 0; j < 8; ++j) { const f32x4 y = v[j] * rs * gv[j]; o8[64 * j] = (unsigned long long)pk2(y.x, y.y) | ((unsigned long long)pk2(y.z, y.w) << 32); }
    }
}
__device__ __forceinline__ void sincos_d(double a, float& sn, float& cs) {
    const double k = __builtin_rint(a * 0.63661977236758134308);
    double r = __builtin_fma(-k, 1.57079632679489655800e+00, a); r = __builtin_fma(-k, 6.12323399573676603587e-17, r);
    const double r2 = r * r;
    double sp = -1.6059043836821613e-10; sp = sp * r2 + 2.5052108385441720e-08; sp = sp * r2 - 2.7557319223985893e-06; sp = sp * r2 + 1.9841269841269841e-04;
    sp = sp * r2 - 8.3333333333333332e-03; sp = sp * r2 + 1.6666666666666666e-01; const double s = r - r * r2 * sp;
    double cp = 2.0876756987868099e-09; cp = cp * r2 - 2.7557319223985888e-07; cp = cp * r2 + 2.4801587301587302e-05; cp = cp * r2 - 1.3888888888888889e-03;
    cp = cp * r2 + 4.1666666666666664e-02; const double c = 1.0 - 0.5 * r2 + r2 * r2 * cp;
    const int q = (int)((long long)k & 3);
    const double so = (q == 0) ? s : (q == 1) ? c : (q == 2) ? -s : -c, co = (q == 0) ? c : (q == 1) ? -s : (q == 2) ? -c : s;
    sn = (float)so; cs = (float)co;
}
__device__ __forceinline__ double rope_freq(int i) {
    return i == 0 ? 1.0 : i == 1 ? 0.19392274474868576 : i == 2 ? 0.037606030930863933 : i == 3 ? 0.0072926647372171093 : i == 4 ? 0.001414213562373095 :
           i == 5 ? 0.0002742481756762073 : i == 6 ? 5.3182958969449883e-05 : 1.031338537721246e-05;
}
__device__ __forceinline__ void tables_phase(Frame& F, const float* lq1, const float* lk1, const float* lq2, const float* lk2) {
    const int NT = F.G * NWAVES * 64, gt = (F.vcu * NWAVES + F.wave) * 64 + F.lane;
    float* rope = (float*)(F.ws + WS_ROPE); float* rtab = (float*)(F.ws + WS_RTAB);
    for (int e = gt; e < T * 8; e += NT) { const int pos = e >> 3, i = e & 7; float sn, cs; sincos_d((double)pos * rope_freq(i), sn, cs); *(GAS f32x2*)(rope + (size_t)e * 2) = (f32x2){cs, sn}; }
    for (int e = gt; e < T * 128; e += NT) { const int pos = e >> 7, j = e & 127;
        const double ang = exp2(-(double)j * (13.287712379549449 / 127.0));
        float sn, cs; sincos_d((double)pos * ang, sn, cs); *(GAS f32x2*)(rtab + (size_t)e * 2) = (f32x2){cs, sn}; }
    if (blockIdx.x == 0 && F.wave < 2) {
        const int l = F.wave; const float q1 = lq1[l * 64 + F.lane], k1 = lk1[l * 64 + F.lane], q2 = lq2[l * 64 + F.lane], k2 = lk2[l * 64 + F.lane];
        const float d1 = wave_sum(q1 * k1), d2 = wave_sum(q2 * k2); const float linit = (l == 0) ? 0.2f : 0.4707130183435842f;
        if (F.lane == 0) ((float*)(F.ws + WS_SMALL))[l] = expf(d1) - expf(d2) + linit;
    }
}
__device__ __forceinline__ void combine_phase(Frame& F, const bf16* O0, const bf16* O1, const float* subg, float lam, float post, bf16* ON) {
    const int NGW = F.G * NWAVES, gw = F.vcu * NWAVES + F.wave;
    f32x4 g0[4], g1[4];
#pragma unroll
    for (int i = 0; i < 4; ++i) { g0[i] = *(const GAS f32x4*)(subg + (F.lane & 15) * 8) * post; g1[i] = *(const GAS f32x4*)(subg + (F.lane & 15) * 8 + 4) * post; }
    for (int m = gw; m < T; m += NGW) {
        const GAS v4u* p0 = (const GAS v4u*)(O0 + (size_t)m * D) + F.lane; const GAS v4u* p1 = (const GAS v4u*)(O1 + (size_t)m * D) + F.lane;
        GAS v4u* po = (GAS v4u*)(ON + (size_t)m * D) + F.lane;
#pragma unroll
        for (int i = 0; i < 4; ++i) {
            const v4u a = p0[64 * i], b = p1[64 * i]; float o[8]; float ss = 0.f;
#pragma unroll
            for (int e = 0; e < 4; ++e) { const unsigned ua = a[e], ub = b[e];
                o[2 * e] = __uint_as_float(ua << 16) - lam * __uint_as_float(ub << 16); o[2 * e + 1] = __uint_as_float(ua & 0xffff0000u) - lam * __uint_as_float(ub & 0xffff0000u);
                ss += o[2 * e] * o[2 * e] + o[2 * e + 1] * o[2 * e + 1]; }
            ss += __shfl_xor(ss, 1); ss += __shfl_xor(ss, 2); ss += __shfl_xor(ss, 4); ss += __shfl_xor(ss, 8);
            const float rs = 1.0f / sqrtf(ss * (1.0f / 128.0f) + NORM_EPS);
            v4u w; w.x = pk2(o[0] * rs * g0[i][0], o[1] * rs * g0[i][1]); w.y = pk2(o[2] * rs * g0[i][2], o[3] * rs * g0[i][3]);
            w.z = pk2(o[4] * rs * g1[i][0], o[5] * rs * g1[i][1]); w.w = pk2(o[6] * rs * g1[i][2], o[7] * rs * g1[i][3]);
            po[64 * i] = w;
        }
    }
}
__device__ __forceinline__ float ret_log2gamma(int h) { return pg8::EpiRetProj::log2gamma(h); }
__device__ __forceinline__ void ret_scan_phase(Frame& F, const bf16* KZT, const bf16* VT, bf16* RT) {
    const int g = F.lane >> 4, fr = F.lane & 15, w = F.wave;
    for (int s = F.vcu; s < 256; s += F.G) {
        const int h = s >> 5, dv0 = 64 * ((s >> 2) & 7) + 16 * (w >> 1), dk0 = 64 * (s & 3) + 32 * (w & 1);
        const float dec = __builtin_amdgcn_exp2f(128.0f * ret_log2gamma(h));
        const bf16* ka = KZT + (size_t)(256 * h + dk0 + fr) * T + 8 * g;
        const bf16* vb = VT + (size_t)(512 * h + dv0 + fr) * T + 8 * g;
        bf16* rt = RT + ((size_t)h * 512 + dv0 + fr) * 256 + dk0 + 4 * g;
        f32x4 acc[2] = {(f32x4){0.f, 0.f, 0.f, 0.f}, (f32x4){0.f, 0.f, 0.f, 0.f}};
        bf16x8 an[2][4], bn[4];
#pragma unroll
        for (int ks = 0; ks < 4; ++ks) { bn[ks] = *(const GAS bf16x8*)(vb + 32 * ks); an[0][ks] = *(const GAS bf16x8*)(ka + 32 * ks); an[1][ks] = *(const GAS bf16x8*)(ka + (size_t)16 * T + 32 * ks); }
        for (int c = 0; c < 128; ++c) {
            bf16x8 a[2][4], b[4];
#pragma unroll
            for (int ks = 0; ks < 4; ++ks) { b[ks] = bn[ks]; a[0][ks] = an[0][ks]; a[1][ks] = an[1][ks]; }
            if (c + 1 < 127) { const int m1 = 128 * (c + 1);
#pragma unroll
                for (int ks = 0; ks < 4; ++ks) { bn[ks] = *(const GAS bf16x8*)(vb + m1 + 32 * ks); an[0][ks] = *(const GAS bf16x8*)(ka + m1 + 32 * ks); an[1][ks] = *(const GAS bf16x8*)(ka + (size_t)16 * T + m1 + 32 * ks); } }
            bf16* rc = rt + (size_t)c * (8 * 512 * 256);
#pragma unroll
            for (int t = 0; t < 2; ++t) { pg8::u32x2 wv; wv.x = pk2(acc[t][0], acc[t][1]); wv.y = pk2(acc[t][2], acc[t][3]); *(GAS pg8::u32x2*)(rc + 16 * t) = wv; }
            if (c == 127) break;
#pragma unroll
            for (int t = 0; t < 2; ++t) { acc[t] = acc[t] * dec;
#pragma unroll
                for (int ks = 0; ks < 4; ++ks) acc[t] = __builtin_amdgcn_mfma_f32_16x16x32_bf16(a[t][ks], b[ks], acc[t], 0, 0, 0); }
        }
    }
}
__device__ __forceinline__ void ret_chunk_phase(Frame& F, const bf16* QR, const bf16* KR, const bf16* VT, bf16* GS, const bf16* RT) {
    const int g = F.lane >> 4, fr = F.lane & 15, w = F.wave;
    for (int unit = F.vcu; unit < 1024; unit += F.G) {
        const int h = unit >> 7, c = unit & 127;
        const float l2g = ret_log2gamma(h);
        const int nrow = 16 * w + fr;
        const size_t row = (size_t)128 * c + nrow;
        bf16x8 qf[8];
#pragma unroll
        for (int ks = 0; ks < 8; ++ks) qf[ks] = *(const GAS bf16x8*)(QR + row * 2048 + 256 * h + 32 * ks + 8 * g);
        pg8::u32x2 pk[8];
#pragma unroll
        for (int mt = 0; mt < 8; ++mt) {
            if (mt <= w) {
                f32x4 s = (f32x4){0.f, 0.f, 0.f, 0.f};
                const bf16* kp = KR + ((size_t)128 * c + 16 * mt + fr) * 2048 + 256 * h + 8 * g;
#pragma unroll
                for (int ks = 0; ks < 8; ++ks) s = __builtin_amdgcn_mfma_f32_16x16x32_bf16(*(const GAS bf16x8*)(kp + 32 * ks), qf[ks], s, 0, 0, 0);
                float pv[4];
#pragma unroll
                for (int r = 0; r < 4; ++r) { const int d = nrow - (16 * mt + 4 * g + r); pv[r] = d >= 0 ? s[r] * __builtin_amdgcn_exp2f(l2g * (float)d) : 0.f; }
                pk[mt].x = pk2(pv[0], pv[1]); pk[mt].y = pk2(pv[2], pv[3]);
            } else { pk[mt].x = 0u; pk[mt].y = 0u; }
        }
        const float xi = __builtin_amdgcn_exp2f(l2g * (float)(nrow + 1));
        const bf16* rp = RT + (((size_t)c * 8 + h) * 512 + fr) * 256 + 8 * g;
        const bf16* vp = VT + (size_t)(512 * h + fr) * T + 128 * c + 4 * g;
        f32x4 Y[32];
#pragma unroll
        for (int dvt = 0; dvt < 32; ++dvt) {
            f32x4 y = (f32x4){0.f, 0.f, 0.f, 0.f};
#pragma unroll
            for (int ks = 0; ks < 8; ++ks) y = __builtin_amdgcn_mfma_f32_16x16x32_bf16(*(const GAS bf16x8*)(rp + (size_t)dvt * 16 * 256 + 32 * ks), qf[ks], y, 0, 0, 0);
            y = y * xi;
#pragma unroll
            for (int k2 = 0; k2 < 4; ++k2) {
                if (2 * k2 <= w) {
                    const pg8::u32x2 lo = *(const GAS pg8::u32x2*)(vp + (size_t)dvt * 16 * T + 32 * k2), hi = *(const GAS pg8::u32x2*)(vp + (size_t)dvt * 16 * T + 32 * k2 + 16);
                    const v4u av = {lo.x, lo.y, hi.x, hi.y}, bv = {pk[2 * k2].x, pk[2 * k2].y, pk[2 * k2 + 1].x, pk[2 * k2 + 1].y};
                    y = __builtin_amdgcn_mfma_f32_16x16x32_bf16(__builtin_bit_cast(bf16x8, av), __builtin_bit_cast(bf16x8, bv), y, 0, 0, 0);
                }
            }
            Y[dvt] = y;
        }
        float sum = 0.f;
#pragma unroll
        for (int dvt = 0; dvt < 32; ++dvt) sum += (Y[dvt][0] + Y[dvt][1]) + (Y[dvt][2] + Y[dvt][3]);
        sum += __shfl_xor(sum, 16); sum += __shfl_xor(sum, 32);
        const float mean = sum * (1.0f / 512.0f); float var = 0.f;
#pragma unroll
        for (int dvt = 0; dvt < 32; ++dvt) { const f32x4 dlt = Y[dvt] - mean; var += (dlt[0] * dlt[0] + dlt[1] * dlt[1]) + (dlt[2] * dlt[2] + dlt[3] * dlt[3]); }
        var += __shfl_xor(var, 16); var += __shfl_xor(var, 32);
        const float rstd = 1.0f / sqrtf(var * (1.0f / 512.0f) + NORM_EPS);
        bf16* gp = GS + row * 4096 + 512 * h + 4 * g;
#pragma unroll
        for (int dvt = 0; dvt < 32; ++dvt) {
            const pg8::u32x2 gv = *(const GAS pg8::u32x2*)(gp + 16 * dvt);
            const float g0 = __uint_as_float(gv.x << 16), g1 = __uint_as_float(gv.x & 0xffff0000u), g2 = __uint_as_float(gv.y << 16), g3 = __uint_as_float(gv.y & 0xffff0000u);
            const f32x4 yh = (Y[dvt] - mean) * rstd;
            pg8::u32x2 o; o.x = pk2(yh[0] * g0, yh[1] * g1); o.y = pk2(yh[2] * g2, yh[3] * g3);
            *(GAS pg8::u32x2*)(gp + 16 * dvt) = o;
        }
    }
}

struct Args { const float* in[26]; float* out; unsigned char* ws; int ph_lo, ph_hi; };
#define INP(k) (args.in[k])
#define XOUT (args.out)
#define PH_ON (lo <= ph && ph < hi)
#define PH_END do { if (lo <= ph && ph + 1 < hi) xcd_barrier(bar); ++ph; } while (0)
#define FFN_GEMMS(WGU, WD, XIN) do { \
        if (PH_ON && EN(2)) { pg8::Gemm gg{((bf16*)(F.ws + WS_XN)), (const bf16*)(F.ws + (WGU)), M, 2 * FF, D}; pg8::StaticOrder S; S.init(M, 2 * FF, F.G, (int)blockIdx.x); \
            pg8::EpiSwiGLU E{(bf16*)(F.ws + WS_H), FF}; pg8::gemm_phase<pg8::EpiSwiGLU, pg8::StaticOrder, PG8_ALIGN, PG8_SP2>(F.lds + RING_OFF, gg, S, E); } \
        PH_END; \
        if (PH_ON && EN(3)) { pg8::Gemm gg{(const bf16*)(F.ws + WS_H), (const bf16*)(F.ws + (WD)), M, D, FF}; pg8::StaticOrder S; S.init(M, D, F.G, (int)blockIdx.x); \
            pg8::EpiResid E{(XIN), XOUT, D, 0.5f}; pg8::gemm_phase<pg8::EpiResid, pg8::StaticOrder, PG8_ALIGN, PG8_SP2>(F.lds + RING_OFF, gg, S, E); } \
        PH_END; } while (0)
#define CONV_FFN(i) do { \
        pfx = conv_matrix(F, INP(2) + (size_t)(i) * D * FF, D, FF, (bf16*)(F.ws + WS_W1GU), 1, 0, pfx); pfx = conv_matrix(F, INP(3) + (size_t)(i) * D * FF, D, FF, (bf16*)(F.ws + WS_W1GU), 2, 0, pfx); \
        pfx = conv_matrix(F, INP(4) + (size_t)(i) * FF * D, FF, D, (bf16*)(F.ws + WS_W1D), 0, 0, pfx); \
        pfx = conv_matrix(F, INP(23) + (size_t)(i) * D * FF, D, FF, (bf16*)(F.ws + WS_W2GU), 1, 0, pfx); pfx = conv_matrix(F, INP(24) + (size_t)(i) * D * FF, D, FF, (bf16*)(F.ws + WS_W2GU), 2, 0, pfx); \
        pfx = conv_matrix(F, INP(25) + (size_t)(i) * FF * D, FF, D, (bf16*)(F.ws + WS_W2D), 0, 0, pfx); } while (0)

template <int lp> __device__ __forceinline__ void layer_pair(const Args& args, Frame& F, unsigned char* lds, const XcdBarrier& bar, const int lo, const int hi, int& ph) {
        {
            const int li = 2 * lp;
            const float* xin = (lp == 0) ? INP(0) : XOUT;
            if (PH_ON) {
                if (EN(0)) { if (lp == 0) tables_phase(F, INP(12), INP(13), INP(14), INP(15));
                int pfx = 0; CONV_FFN(li);
                pfx = conv_matrix(F, INP(6) + (size_t)lp * D * D, D, 2048, (bf16*)(F.ws + WS_WMIX), 3, 0, pfx); pfx = conv_matrix(F, INP(7) + (size_t)lp * D * D, D, 2048, (bf16*)(F.ws + WS_WMIX), 3, 2048, pfx);
                pfx = conv_matrix(F, INP(8) + (size_t)lp * D * D, D, 2048, (bf16*)(F.ws + WS_WMIX), 3, 4096, pfx); pfx = conv_matrix(F, INP(9) + (size_t)lp * D * D, 2048, D, (bf16*)(F.ws + WS_WMIX + 24 * MiB), 0, 0, pfx); }
                if (EN(1)) rmsnorm_phase(F, xin, INP(1) + (size_t)li * D, ((bf16*)(F.ws + WS_XN)));
            }
            PH_END;
            FFN_GEMMS(WS_W1GU, WS_W1D, xin);
            if (PH_ON && EN(1)) rmsnorm_phase(F, XOUT, INP(5) + (size_t)li * D, ((bf16*)(F.ws + WS_XN)));
            PH_END;
            if (PH_ON && EN(4)) {
                pg8::Gemm gg{((bf16*)(F.ws + WS_XN)), (const bf16*)(F.ws + WS_WMIX), M, 6144, D}; pg8::StaticOrder S; S.init(M, 6144, F.G, (int)blockIdx.x);
                pg8::EpiQKVDiff E{(bf16*)(F.ws + WS_Q), (bf16*)(F.ws + WS_K), (bf16*)(F.ws + WS_V), INP(10) + lp * 64, INP(11) + lp * 64, (const float*)(F.ws + WS_ROPE), attn_body::C2};
                pg8::gemm_phase<pg8::EpiQKVDiff, pg8::StaticOrder, PG8_ALIGN, PG8_SP2>(F.lds + RING_OFF, gg, S, E);
            }
            PH_END;
            if (PH_ON && EN(5)) {
                static_assert(attn_body::ATTN_LDS_BYTES <= RING_BYTES && attn_body::ATTN_PITCH == D, "attention body geometry vs frame");
                const attn_body::AttnTensors AT{(const attn_body::bf16*)(F.ws + WS_Q), (const attn_body::bf16*)(F.ws + WS_K), (const attn_body::bf16*)(F.ws + WS_V), (attn_body::bf16*)(F.ws + WS_O0), (attn_body::bf16*)(F.ws + WS_O1)};
                const attn_body::StaticOrder S(F.vcu);
                attn_body::attn_phase<attn_body::StaticOrder>((char*)lds + RING_OFF, AT, S);
            }
            PH_END;
            if (PH_ON && EN(6)) { const float lam = ((const float*)(F.ws + WS_SMALL))[lp]; const float linit = (lp == 0) ? 0.2f : 0.4707130183435842f;
                combine_phase(F, (const bf16*)(F.ws + WS_O0), (const bf16*)(F.ws + WS_O1), INP(16) + lp * 128, lam, 1.0f - linit, (bf16*)(F.ws + WS_ON)); }
            PH_END;
            if (PH_ON && EN(7)) { pg8::Gemm gg{(const bf16*)(F.ws + WS_ON), (const bf16*)(F.ws + WS_WMIX + 24 * MiB), M, D, 2048}; pg8::StaticOrder S; S.init(M, D, F.G, (int)blockIdx.x);
                pg8::EpiResid E{XOUT, XOUT, D, 1.0f}; pg8::gemm_phase<pg8::EpiResid, pg8::StaticOrder, PG8_ALIGN, PG8_SP2>(F.lds + RING_OFF, gg, S, E); }
            PH_END;
            if (PH_ON && EN(1)) rmsnorm_phase(F, XOUT, INP(22) + (size_t)li * D, ((bf16*)(F.ws + WS_XN)));
            PH_END;
            FFN_GEMMS(WS_W2GU, WS_W2D, XOUT);
        }
        {
            const int li = 2 * lp + 1;
            if (PH_ON) {
                if (EN(0)) { int pfx = 0; CONV_FFN(li);
                bf16* WP = (bf16*)(F.ws + WS_WMIX);
                pfx = conv_matrix(F, INP(17) + (size_t)lp * D * 2048, D, 2048, WP, 0, 0, pfx); pfx = conv_matrix(F, INP(18) + (size_t)lp * D * 2048, D, 2048, WP, 0, 2048, pfx);
                pfx = conv_matrix(F, INP(19) + (size_t)lp * D * 4096, D, 4096, WP, 0, 4096, pfx); pfx = conv_matrix(F, INP(20) + (size_t)lp * D * 4096, D, 4096, WP, 0, 8192, pfx);
                pfx = conv_matrix(F, INP(21) + (size_t)lp * 4096 * D, 4096, D, (bf16*)(F.ws + WS_WMIX + 48 * MiB), 0, 0, pfx); }
                if (EN(1)) rmsnorm_phase(F, XOUT, INP(1) + (size_t)li * D, ((bf16*)(F.ws + WS_XN)));
            }
            PH_END;
            FFN_GEMMS(WS_W1GU, WS_W1D, XOUT);
            if (PH_ON && EN(1)) rmsnorm_phase(F, XOUT, INP(5) + (size_t)li * D, ((bf16*)(F.ws + WS_XN)));
            PH_END;
            if (PH_ON && EN(8)) {
                pg8::Gemm gg{((bf16*)(F.ws + WS_XN)), (const bf16*)(F.ws + WS_WMIX), M, 12288, D}; pg8::StaticOrder S; S.init(M, 12288, F.G, (int)blockIdx.x);
                pg8::EpiRetProj E{(bf16*)(F.ws + WS_QR), (bf16*)(F.ws + WS_KR), (bf16*)(F.ws + WS_KZT), (bf16*)(F.ws + WS_VT), (bf16*)(F.ws + WS_GS), (const float*)(F.ws + WS_RTAB), M};
                pg8::gemm_phase<pg8::EpiRetProj, pg8::StaticOrder, PG8_ALIGN, PG8_SP2>(F.lds + RING_OFF, gg, S, E);
            }
            PH_END;
            if (PH_ON && EN(9)) ret_scan_phase(F, (const bf16*)(F.ws + WS_KZT), (const bf16*)(F.ws + WS_VT), (bf16*)(F.ws + WS_RT));
            PH_END;
            if (PH_ON && EN(10)) ret_chunk_phase(F, (const bf16*)(F.ws + WS_QR), (const bf16*)(F.ws + WS_KR), (const bf16*)(F.ws + WS_VT), (bf16*)(F.ws + WS_GS), (const bf16*)(F.ws + WS_RT));
            PH_END;
            if (PH_ON && EN(11)) { pg8::Gemm gg{(const bf16*)(F.ws + WS_GS), (const bf16*)(F.ws + WS_WMIX + 48 * MiB), M, D, 4096}; pg8::StaticOrder S; S.init(M, D, F.G, (int)blockIdx.x);
                pg8::EpiResid E{XOUT, XOUT, D, 1.0f}; pg8::gemm_phase<pg8::EpiResid, pg8::StaticOrder, PG8_ALIGN, PG8_SP2>(F.lds + RING_OFF, gg, S, E); }
            PH_END;
            if (PH_ON && EN(1)) rmsnorm_phase(F, XOUT, INP(22) + (size_t)li * D, ((bf16*)(F.ws + WS_XN)));
            PH_END;
            FFN_GEMMS(WS_W2GU, WS_W2D, XOUT);
        }
    }
#undef PH_ON
#undef PH_END
#undef FFN_GEMMS
#undef CONV_FFN
__global__ void __launch_bounds__(NWAVES * 64, 2) fwd_kernel(Args args) {
    extern __shared__ __attribute__((aligned(16))) unsigned char lds[];
    Frame F;
    F.lds = (LAS unsigned char*)lds;
    F.MISC = (volatile LAS unsigned*)(F.lds + MISC_OFF);
    F.tid = threadIdx.x; F.lane = F.tid & 63; F.wave = __builtin_amdgcn_readfirstlane(F.tid >> 6);
    F.G = gridDim.x; { const int bx = blockIdx.x; F.vcu = (F.G % 8 == 0) ? (bx % 8) * (F.G / 8) + bx / 8 : bx; }
    F.ws = args.ws; F.ctl = (gu32*)(args.ws + WS_CTL);
    for (int u = F.tid; u < (LDS_BYTES - LDSCTL_OFF) / 4; u += NWAVES * 64) ((LAS unsigned*)(F.lds + LDSCTL_OFF))[u] = 0u;
    __syncthreads();
    const int lo = args.ph_lo, hi = args.ph_hi;
    XcdBarrier bar; bar.bar = (unsigned*)(F.ctl + CW_BAR); bar.x = 0; bar.st = nullptr;
    if (hi - lo > 1) bar = xcd_barrier_post((unsigned*)(F.ctl + CW_BAR), F.MISC + 8);
    int ph = 0;
    layer_pair<0>(args, F, lds, bar, lo, hi, ph);
    layer_pair<1>(args, F, lds, bar, lo, hi, ph);
}

extern "C" void kernel_launch(void* const* d_in, const int* in_sizes, int n_in, void* d_out, int out_size, void* d_ws, size_t ws_size, hipStream_t stream) {
    static int grid = 0;
    if (grid == 0) {
        if (n_in != 26 || in_sizes[0] != M * D || out_size != M * D || ws_size < WS_END) { fprintf(stderr, "kernel_launch: unexpected shapes / workspace (n_in %d, ws %zu)\n", n_in, ws_size); grid = -1; return; }
        int dev = 0, cus = 0, per_cu = 0;
        if (hipGetDevice(&dev) != hipSuccess || hipDeviceGetAttribute(&cus, hipDeviceAttributeMultiprocessorCount, dev) != hipSuccess) { grid = -1; return; }
        if (hipFuncSetAttribute((const void*)fwd_kernel, hipFuncAttributeMaxDynamicSharedMemorySize, LDS_BYTES) != hipSuccess) { fprintf(stderr, "kernel_launch: hipFuncSetAttribute failed\n"); grid = -1; return; }
        if (hipOccupancyMaxActiveBlocksPerMultiprocessor(&per_cu, (const void*)fwd_kernel, NWAVES * 64, LDS_BYTES) != hipSuccess || per_cu < 1) { fprintf(stderr, "kernel_launch: occupancy query reports %d\n", per_cu); }
        (void)hipGetLastError();
        grid = cus;
        if (grid != 256) { fprintf(stderr, "kernel_launch: built for 256 CUs, found %d\n", cus); grid = -1; return; }
    }
    if (grid < 0) return;
    if (hipMemsetAsync((char*)d_ws + WS_CTL, 0, CTL_ZERO_BYTES, stream) != hipSuccess) return;
    Args a{};
    for (int i = 0; i < 26; ++i) a.in[i] = (const float*)d_in[i];
    a.out = (float*)d_out; a.ws = (unsigned char*)d_ws;
#if MK_SPLIT
    for (int p = 0; p < N_PHASES; ++p) { a.ph_lo = p; a.ph_hi = p + 1; hipLaunchKernelGGL(fwd_kernel, dim3(grid), dim3(NWAVES * 64), LDS_BYTES, stream, a); }
#else
    a.ph_lo = 0; a.ph_hi = N_PHASES;
    hipLaunchKernelGGL(fwd_kernel, dim3(grid), dim3(NWAVES * 64), LDS_BYTES, stream, a);
#endif
}
```

```cpp
#include <hip/hip_runtime.h>
#include <hip/hip_bf16.h>
#include <cstdio>
#include <cstdint>
#include <cmath>
namespace pg8 {
#define PG8_LAS __attribute__((address_space(3)))
typedef unsigned short bf16_t;
typedef short bf16x8 __attribute__((ext_vector_type(8)));
typedef float f32x4 __attribute__((ext_vector_type(4)));
typedef unsigned u32x4 __attribute__((ext_vector_type(4)));
constexpr int BM = 256, BK = 64, HALF = 128, HTB = HALF * BK * 2  , STAGE_BYTES = 8 * HTB, NXCD = 8, WGM = 8;

__host__ __device__ __forceinline__ int lds_byte(int r, int c) { const int st = (r >> 4) * 2 + (c >> 5), rr = r & 15, cc = c & 31, ob = rr * 64 + cc * 2; return st * 1024 + (ob ^ (((ob >> 9) & 1) << 5)); }
__host__ __device__ __forceinline__ void stage_rc(int b, int& R, int& C) { const int st = b / 1024, sb = b % 1024, swz = sb ^ (((sb >> 9) & 1) << 5); R = (st >> 1) * 16 + swz / 64; C = (st & 1) * 32 + (swz % 64) / 2; }
__host__ __device__ __forceinline__ int perm32(int rho) { const int n = rho >> 4, i = rho & 15; return 8 * (i >> 2) + 4 * n + (i & 3); }

struct Unit { int pm, pn; };
struct Gemm { const bf16_t* A; const bf16_t* Bt; int M, N, K; };

struct StaticOrder {
    int nM, nN, nwg, G, c;
    __host__ __device__ void init(int M, int N, int G_, int c_) { nM = M / BM; nN = N / BM; nwg = nM * nN; G = G_; c = c_; }
    __host__ __device__ bool next(int i, Unit& u) const {
        const long L = (long)i * G + c; if (L >= nwg) return false;
        int wgid = (int)L; { const int q = nwg / NXCD, r = nwg % NXCD, xcd = wgid % NXCD, off = wgid / NXCD; wgid = (xcd < r ? xcd * (q + 1) : r * (q + 1) + (xcd - r) * q) + off; }
        const int nig = WGM * nN, gid = wgid / nig, fm = gid * WGM, gsz = (nM - fm) < WGM ? (nM - fm) : WGM;
        u.pm = fm + ((wgid % nig) % gsz); u.pn = (wgid % nig) / gsz; return true;
    }
    __device__ __forceinline__ void a_ready(const Unit&) const {}
    __device__ __forceinline__ void done(const Unit&) const {}
};

__device__ __forceinline__ unsigned cvt_pk_bf16(float lo, float hi) { unsigned r; asm volatile("v_cvt_pk_bf16_f32 %0, %1, %2" : "=v"(r) : "v"(lo), "v"(hi)); return r; }
typedef float f32x2 __attribute__((ext_vector_type(2)));
typedef unsigned u32x2 __attribute__((ext_vector_type(2)));
__device__ __forceinline__ float silu_f(float g) { return g * __builtin_amdgcn_rcpf(1.0f + __builtin_amdgcn_exp2f(-1.4426950408889634f * g)); }
__device__ __forceinline__ f32x2 silu2_mul(const f32x2 g, const f32x2 u) {
    const f32x2 t = g * (f32x2){-1.4426950408889634f, -1.4426950408889634f};
    const f32x2 d = (f32x2){__builtin_amdgcn_exp2f(t.x), __builtin_amdgcn_exp2f(t.y)} + (f32x2){1.0f, 1.0f};
    const f32x2 r = {__builtin_amdgcn_rcpf(d.x), __builtin_amdgcn_rcpf(d.y)};
    return (g * r) * u;
}
__device__ __forceinline__ u32x4 pack8(const f32x4 a, const f32x4 b) { u32x4 w; w.x = cvt_pk_bf16(a[0], a[1]); w.y = cvt_pk_bf16(a[2], a[3]); w.z = cvt_pk_bf16(b[0], b[1]); w.w = cvt_pk_bf16(b[2], b[3]); return w; }
__device__ __forceinline__ bf16_t f2bf1(float f) { return (bf16_t)(cvt_pk_bf16(f, 0.f) & 0xffffu); }

struct EpiSwiGLU {
    static constexpr bool PERM = true, AFTER_DRAIN = false;
    bf16_t* O; int ldc;
    __device__ __forceinline__ void operator()(const f32x4 (&acc)[2][2][4][2], const Unit& u, int wr, int wc, int fr, int fq) const {
        const int row0 = u.pm * BM + wr * 64 + fr, col0 = u.pn * HALF + wc * 32 + 8 * fq;
#pragma unroll
        for (int ai = 0; ai < 2; ++ai)
#pragma unroll
            for (int m = 0; m < 4; ++m) {
                f32x4 v0, v1;
#pragma unroll
                for (int j = 0; j < 4; j += 2) { const f32x2 a = silu2_mul((f32x2){acc[ai][0][m][0][j], acc[ai][0][m][0][j + 1]}, (f32x2){acc[ai][1][m][0][j], acc[ai][1][m][0][j + 1]});
                    const f32x2 b = silu2_mul((f32x2){acc[ai][0][m][1][j], acc[ai][0][m][1][j + 1]}, (f32x2){acc[ai][1][m][1][j], acc[ai][1][m][1][j + 1]});
                    v0[j] = a.x; v0[j + 1] = a.y; v1[j] = b.x; v1[j + 1] = b.y; }
                *(u32x4*)(O + (size_t)(row0 + ai * HALF + m * 16) * ldc + col0) = pack8(v0, v1);
            }
    }
};
struct EpiResid {
    static constexpr bool PERM = false, AFTER_DRAIN = false;
    const float* base; float* out; int ldc; float scale;
    __device__ __forceinline__ void operator()(const f32x4 (&acc)[2][2][4][2], const Unit& u, int wr, int wc, int fr, int fq) const {
        const int row0 = u.pm * BM + wr * 64 + fr, col0 = u.pn * BM + wc * 32 + 4 * fq;
#pragma unroll
        for (int ai = 0; ai < 2; ++ai) {
            f32x4 b[4][2][2];
#pragma unroll
            for (int m = 0; m < 4; ++m) { const size_t off = (size_t)(row0 + ai * HALF + m * 16) * ldc + col0;
#pragma unroll
                for (int bj = 0; bj < 2; ++bj)
#pragma unroll
                    for (int n = 0; n < 2; ++n) b[m][bj][n] = *(const f32x4*)(base + off + bj * HALF + n * 16); }
#pragma unroll
            for (int m = 0; m < 4; ++m) { const size_t off = (size_t)(row0 + ai * HALF + m * 16) * ldc + col0;
#pragma unroll
                for (int bj = 0; bj < 2; ++bj)
#pragma unroll
                    for (int n = 0; n < 2; ++n) *(f32x4*)(out + off + bj * HALF + n * 16) = b[m][bj][n] + acc[ai][bj][m][n] * scale; }
        }
    }
};
struct EpiQKVDiff {
    static constexpr bool PERM = true, AFTER_DRAIN = false;
    bf16_t *Q, *K, *V; const float* qg; const float* kg; const float* rope; float qscale; int Mrows;
    __device__ __forceinline__ void operator()(const f32x4 (&acc)[2][2][4][2], const Unit& u, int wr, int wc, int fr, int fq) const {
        const int sec = u.pn >> 3, colbase = (u.pn & 7) * 256 + wc * 64 + 8 * fq, row0 = u.pm * BM + wr * 64 + fr;
        if (sec == 2) {
#pragma unroll
            for (int ai = 0; ai < 2; ++ai)
#pragma unroll
                for (int m = 0; m < 4; ++m) { bf16_t* rp = V + ((size_t)(colbase >> 7) * Mrows + (row0 + ai * HALF + m * 16)) * 128 + (colbase & 127);
#pragma unroll
                    for (int bj = 0; bj < 2; ++bj) *(u32x4*)(rp + 32 * bj) = pack8(acc[ai][bj][m][0], acc[ai][bj][m][1]); }
        } else {
            const float* gp = sec == 0 ? qg : kg; bf16_t* dst = sec == 0 ? Q : K; const float sc = sec == 0 ? qscale : 1.0f;
            f32x4 gv[2][2];
#pragma unroll
            for (int bj = 0; bj < 2; ++bj)
#pragma unroll
                for (int n = 0; n < 2; ++n) gv[bj][n] = *(const f32x4*)(gp + 32 * bj + 8 * fq + 4 * n) * sc;
            const float sgn = (fq == 0) ? -1.0f : 1.0f; const bool rot = fq < 2;
            f32x4 tn0, tn1, tn2, tn3;
            { const f32x4* tr = (const f32x4*)(rope + (size_t)row0 * 16); tn0 = tr[0]; tn1 = tr[1]; tn2 = tr[2]; tn3 = tr[3]; }
#pragma unroll
            for (int ai = 0; ai < 2; ++ai)
#pragma unroll
                for (int m = 0; m < 4; ++m) {
                    const int row = row0 + ai * HALF + m * 16;
                    const f32x4 t0 = tn0, t1 = tn1, t2 = tn2, t3 = tn3;
                    if (ai * 4 + m + 1 < 8) { const int nrow_ = row0 + ((ai * 4 + m + 1) >> 2) * HALF + ((ai * 4 + m + 1) & 3) * 16;
                        const f32x4* tr = (const f32x4*)(rope + (size_t)nrow_ * 16); tn0 = tr[0]; tn1 = tr[1]; tn2 = tr[2]; tn3 = tr[3]; }
                    f32x4 a00 = acc[ai][0][m][0], a01 = acc[ai][0][m][1], a10 = acc[ai][1][m][0], a11 = acc[ai][1][m][1];
                    float ss = 0.f;
#pragma unroll
                    for (int j = 0; j < 4; ++j) ss += a00[j] * a00[j] + a01[j] * a01[j] + a10[j] * a10[j] + a11[j] * a11[j];
                    ss += __shfl_xor(ss, 16); ss += __shfl_xor(ss, 32);
                    const float rs = __builtin_amdgcn_rsqf(ss * (1.0f / 64.0f) + 1e-6f);
                    f32x4 y00 = a00 * rs * gv[0][0], y01 = a01 * rs * gv[0][1]; const f32x4 y10 = a10 * rs * gv[1][0], y11 = a11 * rs * gv[1][1];
                    f32x4 p0, p1;
#pragma unroll
                    for (int j = 0; j < 4; ++j) { p0[j] = __shfl_xor(y00[j], 16); p1[j] = __shfl_xor(y01[j], 16); }
                    f32x4 r0, r1;
                    r0[0] = y00[0] * t0[0] + sgn * p0[0] * t0[1]; r0[1] = y00[1] * t0[2] + sgn * p0[1] * t0[3];
                    r0[2] = y00[2] * t1[0] + sgn * p0[2] * t1[1]; r0[3] = y00[3] * t1[2] + sgn * p0[3] * t1[3];
                    r1[0] = y01[0] * t2[0] + sgn * p1[0] * t2[1]; r1[1] = y01[1] * t2[2] + sgn * p1[1] * t2[3];
                    r1[2] = y01[2] * t3[0] + sgn * p1[2] * t3[1]; r1[3] = y01[3] * t3[2] + sgn * p1[3] * t3[3];
                    if (rot) { y00 = r0; y01 = r1; }
                    bf16_t* rp = dst + ((size_t)(colbase >> 6) * Mrows + row) * 64 + (colbase & 63);
                    *(u32x4*)(rp) = pack8(y00, y01); *(u32x4*)(rp + 32) = pack8(y10, y11);
                }
        }
    }
};
__device__ __forceinline__ float dpp_x1(float x) { return __int_as_float(__builtin_amdgcn_mov_dpp(__float_as_int(x), 0xB1, 0xF, 0xF, true)); }
__device__ __forceinline__ float dpp_x2(float x) { return __int_as_float(__builtin_amdgcn_mov_dpp(__float_as_int(x), 0x4E, 0xF, 0xF, true)); }
__device__ __forceinline__ void quad_tr(float (&a)[4], bool o1, bool o2) {
    { const float r = dpp_x1(o1 ? a[0] : a[1]); if (o1) a[0] = r; else a[1] = r; }
    { const float r = dpp_x1(o1 ? a[2] : a[3]); if (o1) a[2] = r; else a[3] = r; }
    { const float r = dpp_x2(o2 ? a[0] : a[2]); if (o2) a[0] = r; else a[2] = r; }
    { const float r = dpp_x2(o2 ? a[1] : a[3]); if (o2) a[1] = r; else a[3] = r; }
}
struct EpiRetProj {
    static constexpr bool PERM = true, AFTER_DRAIN = false;
    bf16_t *QR, *KR, *KZT, *VT, *GS; const float* tab;
    __device__ __forceinline__ static float log2gamma(int h) {
        return h == 0 ? -0.045803689613124789f : h == 1 ? -0.022720076500083529f : h == 2 ? -0.011315313227834146f : h == 3 ? -0.0056465631411420627f :
               h == 4 ? -0.0028205190623786626f : h == 5 ? -0.0014095702546713536f : h == 6 ? -0.00070461297658937271f : -0.00035226347162902138f;
    }
    __device__ __forceinline__ static size_t qk_off(int tok, int h, int dim0) { return ((((size_t)(tok >> 4) * 8 + h) * 8 + (dim0 >> 5)) * 64 + (tok & 15) + 16 * ((dim0 & 31) >> 3)) * 8; }
    __device__ __forceinline__ static size_t tr_off(int r, int tok) { const int p = 8 * ((tok & 15) >> 2) + 4 * ((tok >> 4) & 1) + (tok & 3);
        return ((((size_t)(r >> 4) * 512 + (tok >> 5)) * 64) + (r & 15) + 16 * (p >> 3)) * 8 + (p & 7); }
    __device__ __forceinline__ void operator()(const f32x4 (&acc)[2][2][4][2], const Unit& u, int wr, int wc, int fr, int fq) const {
        const int pn = u.pn, row0 = u.pm * BM + wr * 64 + fr, cl = wc * 32 + 8 * fq;
        const bool o1 = fr & 1, o2 = fr & 2; const int qd = fr >> 2, rl = fr & 3;
        if (pn < 16) {
            const bool isk = pn >= 8; const int h = pn & 7; const float sc = isk ? 0.0625f : 1.0f; bf16_t* dst = isk ? KR : QR; const float l2g = log2gamma(h);
            f32x4 tq[2][2];
#define RP_TLOAD(ib_) do { const int ai_ = (ib_) >> 2, mp_ = ((ib_) >> 1) & 1, bj_ = (ib_) & 1; _Pragma("unroll") for (int mm_ = 0; mm_ < 2; ++mm_) { \
                const f32x4* tp_ = (const f32x4*)(tab + ((size_t)(row0 + ai_ * HALF + (2 * mp_ + mm_) * 16) * 128 + ((128 * bj_ + cl) >> 1)) * 2); tq[mm_][0] = tp_[0]; tq[mm_][1] = tp_[1]; } } while (0)
            RP_TLOAD(0);
#pragma unroll
            for (int ai = 0; ai < 2; ++ai)
#pragma unroll
                for (int mp = 0; mp < 2; ++mp)
#pragma unroll
                    for (int bj = 0; bj < 2; ++bj) {
                        const int dim0 = 128 * bj + cl;
                        float rz[2][8];
                        const f32x4 tc[2][2] = {{tq[0][0], tq[0][1]}, {tq[1][0], tq[1][1]}};
                        if ((ai * 2 + mp) * 2 + bj + 1 < 8) RP_TLOAD((ai * 2 + mp) * 2 + bj + 1);
#pragma unroll
                        for (int mm = 0; mm < 2; ++mm) {
                            const int m = 2 * mp + mm, row = row0 + ai * HALF + m * 16;
                            const float zeta = __builtin_amdgcn_exp2f(l2g * (float)(127 - (row & 127)));
                            const f32x4 t0 = tc[mm][0], t1 = tc[mm][1];
                            const f32x4 a0 = acc[ai][bj][m][0], a1 = acc[ai][bj][m][1];
                            f32x4 r0, r1;
                            r0[0] = a0[0] * t0[0] - a0[1] * t0[1]; r0[1] = a0[1] * t0[0] + a0[0] * t0[1];
                            r0[2] = a0[2] * t0[2] - a0[3] * t0[3]; r0[3] = a0[3] * t0[2] + a0[2] * t0[3];
                            r1[0] = a1[0] * t1[0] - a1[1] * t1[1]; r1[1] = a1[1] * t1[0] + a1[0] * t1[1];
                            r1[2] = a1[2] * t1[2] - a1[3] * t1[3]; r1[3] = a1[3] * t1[2] + a1[2] * t1[3];
                            r0 = r0 * sc; r1 = r1 * sc;
                            *(u32x4*)(dst + qk_off(row, h, dim0)) = pack8(r0, r1);
#pragma unroll
                            for (int j = 0; j < 4; ++j) { rz[mm][j] = r0[j] * zeta; rz[mm][4 + j] = r1[j] * zeta; }
                        }
                        if (isk) {
                            const int tok0 = row0 - fr + ai * HALF + 32 * mp;
#pragma unroll
                            for (int n = 0; n < 2; ++n) {
                                float ea[4] = {rz[0][4 * n], rz[0][4 * n + 1], rz[0][4 * n + 2], rz[0][4 * n + 3]}, oa[4] = {rz[1][4 * n], rz[1][4 * n + 1], rz[1][4 * n + 2], rz[1][4 * n + 3]};
                                quad_tr(ea, o1, o2); quad_tr(oa, o1, o2);
                                const int rr = 256 * h + dim0 + 4 * n + rl;
                                u32x4 w; w.x = cvt_pk_bf16(ea[0], ea[1]); w.y = cvt_pk_bf16(ea[2], ea[3]); w.z = cvt_pk_bf16(oa[0], oa[1]); w.w = cvt_pk_bf16(oa[2], oa[3]);
                                *(u32x4*)(KZT + ((((size_t)(rr >> 4) * 512 + (tok0 >> 5)) * 64) + (rr & 15) + 16 * qd) * 8) = w;
                            }
                        }
                    }
#undef RP_TLOAD
        } else if (pn < 32) {
#pragma unroll
            for (int ai = 0; ai < 2; ++ai)
#pragma unroll
                for (int mp = 0; mp < 2; ++mp)
#pragma unroll
                    for (int bj = 0; bj < 2; ++bj) {
                        const int tok0 = row0 - fr + ai * HALF + 32 * mp, c0 = (pn - 16) * 256 + 128 * bj + cl;
#pragma unroll
                        for (int n = 0; n < 2; ++n) {
                            float ea[4] = {acc[ai][bj][2 * mp][n][0], acc[ai][bj][2 * mp][n][1], acc[ai][bj][2 * mp][n][2], acc[ai][bj][2 * mp][n][3]};
                            float oa[4] = {acc[ai][bj][2 * mp + 1][n][0], acc[ai][bj][2 * mp + 1][n][1], acc[ai][bj][2 * mp + 1][n][2], acc[ai][bj][2 * mp + 1][n][3]};
                            quad_tr(ea, o1, o2); quad_tr(oa, o1, o2);
                            const int rr = c0 + 4 * n + rl;
                            u32x4 w; w.x = cvt_pk_bf16(ea[0], ea[1]); w.y = cvt_pk_bf16(ea[2], ea[3]); w.z = cvt_pk_bf16(oa[0], oa[1]); w.w = cvt_pk_bf16(oa[2], oa[3]);
                            *(u32x4*)(VT + ((((size_t)(rr >> 4) * 512 + (tok0 >> 5)) * 64) + (rr & 15) + 16 * qd) * 8) = w;
                        }
                    }
        } else {
#pragma unroll
            for (int ai = 0; ai < 2; ++ai)
#pragma unroll
                for (int m = 0; m < 4; ++m) {
                    const int row = row0 + ai * HALF + m * 16;
#pragma unroll
                    for (int bj = 0; bj < 2; ++bj) { f32x4 v0, v1;
#pragma unroll
                        for (int j = 0; j < 4; j += 2) { const f32x2 a = silu2_mul((f32x2){acc[ai][bj][m][0][j], acc[ai][bj][m][0][j + 1]}, (f32x2){1.0f, 1.0f}), b = silu2_mul((f32x2){acc[ai][bj][m][1][j], acc[ai][bj][m][1][j + 1]}, (f32x2){1.0f, 1.0f});
                            v0[j] = a.x; v0[j + 1] = a.y; v1[j] = b.x; v1[j + 1] = b.y; }
                        *(u32x4*)(GS + (size_t)row * 4096 + (pn - 32) * 256 + 128 * bj + cl) = pack8(v0, v1); }
                }
        }
    }
};
template <class Epi, class Sched, bool ALIGN_EPI = false, bool SP2 = false>
__device__ __forceinline__ void gemm_phase(PG8_LAS unsigned char* lds, const Gemm g, const Sched& S, const Epi& E) {
    int tid_ = threadIdx.x; asm volatile("" : "+v"(tid_));
    const int tid = tid_, wid = __builtin_amdgcn_readfirstlane(tid >> 6), lane = tid & 63, wr = wid >> 2, wc = wid & 3, fr = lane & 15, fq = lane >> 4;
    const int K = g.K, nt = K / BK;
    unsigned voffA[2], voffB[2];
#pragma unroll
    for (int i = 0; i < 2; ++i) { int R, C; stage_rc(tid * 16 + i * 8192, R, C); const int Rb = Epi::PERM ? ((R & ~31) + perm32(R & 31)) : R;
        voffA[i] = (unsigned)(R * K + C) * 2u; voffB[i] = (unsigned)(Rb * K + C) * 2u; }
    const size_t kstep = (size_t)(BK * 2);
    const size_t hstep = (size_t)HALF * K * 2;
    const size_t tstep = 2 * hstep;
    const unsigned ldsw = (unsigned)wid * 1024u;
    const int aoff = lds_byte(wr * 64 + fr, fq * 8), boff = lds_byte(wc * 32 + fr, fq * 8);
#define PG8_SA(b, h) (((b) * 2 + (h)) * HTB)
#define PG8_SB(b, h) ((4 + (b) * 2 + (h)) * HTB)
#define PG8_STAGE(bufoff, gbase, voff) do { _Pragma("unroll") for (int _i = 0; _i < 2; ++_i) \
        __builtin_amdgcn_global_load_lds((const unsigned*)((const char*)(gbase) + (voff)[_i]), (PG8_LAS unsigned*)(lds + (bufoff) + ldsw + _i * 8192), 16, 0, 0); } while (0)
#define PG8_LDA(dst, b, h) do { _Pragma("unroll") for (int m = 0; m < 4; ++m) _Pragma("unroll") for (int k = 0; k < 2; ++k) dst[m][k] = *(const PG8_LAS bf16x8*)(lds + PG8_SA(b, h) + aoff + m * 2048 + k * 1024); } while (0)
#define PG8_LDB(dst, b, h) do { _Pragma("unroll") for (int n = 0; n < 2; ++n) _Pragma("unroll") for (int k = 0; k < 2; ++k) dst[n][k] = *(const PG8_LAS bf16x8*)(lds + PG8_SB(b, h) + boff + n * 2048 + k * 1024); } while (0)
#define PG8_MMA(ai, bj, At, Bt) do { __builtin_amdgcn_s_setprio(1); _Pragma("unroll") for (int m = 0; m < 4; ++m) _Pragma("unroll") for (int n = 0; n < 2; ++n) _Pragma("unroll") for (int k = 0; k < 2; ++k) \
        acc[ai][bj][m][n] = __builtin_amdgcn_mfma_f32_16x16x32_bf16(Bt[n][k], At[m][k], acc[ai][bj][m][n], 0, 0, 0); __builtin_amdgcn_s_setprio(0); } while (0)
#define PG8_WAIT_V(n) asm volatile("s_waitcnt vmcnt(" #n ")" ::: "memory")
#define PG8_WAIT_L(n) asm volatile("s_waitcnt lgkmcnt(" #n ")" ::: "memory")
#define PG8_BAR __builtin_amdgcn_s_barrier()
#define PG8_SCHED __builtin_amdgcn_sched_barrier(0)
    Unit cur, nxt; int ui = 0;
    if (!S.next(0, cur)) return;
    f32x4 acc[2][2][4][2];
#pragma unroll
    for (int a = 0; a < 2; ++a)
#pragma unroll
        for (int b = 0; b < 2; ++b)
#pragma unroll
            for (int m = 0; m < 4; ++m)
#pragma unroll
                for (int n = 0; n < 2; ++n) acc[a][b][m][n] = (f32x4){0.f, 0.f, 0.f, 0.f};
    bf16x8 At[4][2], B0[2][2], B1[2][2];
    const char* cA = (const char*)g.A + (size_t)cur.pm * tstep; const char* cB = (const char*)g.Bt + (size_t)cur.pn * tstep;
    S.a_ready(cur);
    if constexpr (SP2) {
        PG8_STAGE(PG8_SB(0, 0), cB, voffB); PG8_STAGE(PG8_SB(0, 1), cB + hstep, voffB); PG8_STAGE(PG8_SA(0, 0), cA, voffA); PG8_STAGE(PG8_SA(0, 1), cA + hstep, voffA);
        if (wr == 1) PG8_BAR;
        PG8_WAIT_V(2); PG8_BAR;
        PG8_STAGE(PG8_SB(1, 0), cB + kstep, voffB); PG8_STAGE(PG8_SA(1, 0), cA + kstep, voffA); PG8_STAGE(PG8_SB(1, 1), cB + hstep + kstep, voffB);
        PG8_WAIT_V(6); PG8_BAR;
    } else {
        PG8_STAGE(PG8_SB(0, 0), cB, voffB); PG8_STAGE(PG8_SA(0, 0), cA, voffA); PG8_STAGE(PG8_SB(0, 1), cB + hstep, voffB); PG8_STAGE(PG8_SA(0, 1), cA + hstep, voffA);
        if (wr == 1) PG8_BAR;
        PG8_WAIT_V(4); PG8_BAR;
        PG8_STAGE(PG8_SB(1, 0), cB + kstep, voffB); PG8_STAGE(PG8_SA(1, 0), cA + kstep, voffA); PG8_STAGE(PG8_SB(1, 1), cB + hstep + kstep, voffB);
        PG8_WAIT_V(6); PG8_BAR;
    }
    for (;;) {
        const bool has_next = S.next(ui + 1, nxt);
        const char* nA = has_next ? (const char*)g.A + (size_t)nxt.pm * tstep : cA; const char* nB = has_next ? (const char*)g.Bt + (size_t)nxt.pn * tstep : cB;
        for (int t = 0; t < nt; t += 2) {
            const bool last = (t == nt - 2);
            const char* a1 = cA + (size_t)(t + 1) * kstep;
            const char* a2 = last ? nA : cA + (size_t)(t + 2) * kstep; const char* b2 = last ? nB : cB + (size_t)(t + 2) * kstep;
            const char* a3 = a2 + kstep; const char* b3 = b2 + kstep;
            if (last && has_next) S.a_ready(nxt);
            if constexpr (SP2) {
            PG8_LDB(B0, 0, 0); PG8_LDB(B1, 0, 1); PG8_SCHED; PG8_LDA(At, 0, 0); PG8_STAGE(PG8_SA(1, 1), a1 + hstep, voffA);
            PG8_WAIT_V(8); PG8_WAIT_L(0); PG8_BAR; PG8_MMA(0, 0, At, B0); PG8_MMA(0, 1, At, B1); PG8_BAR; PG8_SCHED;
            PG8_LDA(At, 0, 1); PG8_STAGE(PG8_SB(0, 0), b2, voffB); PG8_STAGE(PG8_SB(0, 1), b2 + hstep, voffB); PG8_STAGE(PG8_SA(0, 0), a2, voffA);
            PG8_WAIT_V(8); PG8_WAIT_L(0); PG8_BAR; PG8_MMA(1, 0, At, B0); PG8_MMA(1, 1, At, B1); PG8_BAR; PG8_SCHED;
            PG8_LDB(B0, 1, 0); PG8_LDB(B1, 1, 1); PG8_SCHED; PG8_LDA(At, 1, 0); PG8_STAGE(PG8_SA(0, 1), a2 + hstep, voffA);
            PG8_WAIT_V(8); PG8_WAIT_L(0); PG8_BAR; PG8_MMA(0, 0, At, B0); PG8_MMA(0, 1, At, B1); PG8_BAR; PG8_SCHED;
            PG8_LDA(At, 1, 1); PG8_STAGE(PG8_SB(1, 0), b3, voffB); PG8_STAGE(PG8_SB(1, 1), b3 + hstep, voffB); PG8_STAGE(PG8_SA(1, 0), a3, voffA);
            PG8_WAIT_V(8); PG8_WAIT_L(0); PG8_BAR; PG8_MMA(1, 0, At, B0); PG8_MMA(1, 1, At, B1); PG8_BAR; PG8_SCHED;
            } else {
            PG8_LDB(B0, 0, 0); PG8_SCHED; PG8_LDA(At, 0, 0); PG8_STAGE(PG8_SA(1, 1), a1 + hstep, voffA);
            PG8_WAIT_L(8); PG8_BAR; PG8_WAIT_L(0); PG8_MMA(0, 0, At, B0); PG8_BAR; PG8_SCHED;
            PG8_LDB(B1, 0, 1); PG8_STAGE(PG8_SB(0, 0), b2, voffB);
            PG8_BAR; PG8_WAIT_L(0); PG8_MMA(0, 1, At, B1); PG8_BAR;
            PG8_LDA(At, 0, 1); PG8_STAGE(PG8_SA(0, 0), a2, voffA);
            PG8_BAR; PG8_WAIT_L(0); PG8_MMA(1, 0, At, B0); PG8_BAR; PG8_SCHED;
            PG8_STAGE(PG8_SB(0, 1), b2 + hstep, voffB);
            PG8_WAIT_V(6); PG8_BAR; PG8_MMA(1, 1, At, B1); PG8_BAR;
            PG8_LDB(B0, 1, 0); PG8_SCHED; PG8_LDA(At, 1, 0); PG8_STAGE(PG8_SA(0, 1), a2 + hstep, voffA);
            PG8_WAIT_L(8); PG8_BAR; PG8_WAIT_L(0); PG8_MMA(0, 0, At, B0); PG8_BAR; PG8_SCHED;
            PG8_LDB(B1, 1, 1); PG8_STAGE(PG8_SB(1, 0), b3, voffB);
            PG8_BAR; PG8_WAIT_L(0); PG8_MMA(0, 1, At, B1); PG8_BAR;
            PG8_LDA(At, 1, 1); PG8_STAGE(PG8_SA(1, 0), a3, voffA);
            PG8_BAR; PG8_WAIT_L(0); PG8_MMA(1, 0, At, B0); PG8_BAR; PG8_SCHED;
            PG8_STAGE(PG8_SB(1, 1), b3 + hstep, voffB);
            PG8_WAIT_V(6); PG8_BAR; PG8_MMA(1, 1, At, B1); PG8_BAR;
            }
        }
        if constexpr (ALIGN_EPI) { if (wr == 0) PG8_BAR; }
        if constexpr (!Epi::AFTER_DRAIN) { E(acc, cur, wr, wc, fr, fq); S.done(cur); }
        if (!has_next) break;
#pragma unroll
        for (int a = 0; a < 2; ++a)
#pragma unroll
            for (int b = 0; b < 2; ++b)
#pragma unroll
                for (int m = 0; m < 4; ++m)
#pragma unroll
                    for (int n = 0; n < 2; ++n) acc[a][b][m][n] = (f32x4){0.f, 0.f, 0.f, 0.f};
        cur = nxt; cA = nA; cB = nB; ++ui;
        if constexpr (ALIGN_EPI) { if (wr == 1) PG8_BAR; }
    }
    PG8_WAIT_V(0);
    if constexpr (!ALIGN_EPI) { if (wr == 0) PG8_BAR; }
    PG8_BAR;
    if constexpr (Epi::AFTER_DRAIN) { E.fused(acc, cur, wr, wc, fr, fq, lds, wid, lane); S.done(cur); }
#undef PG8_SA
#undef PG8_SB
#undef PG8_STAGE
#undef PG8_LDA
#undef PG8_LDB
#undef PG8_MMA
#undef PG8_WAIT_V
#undef PG8_WAIT_L
#undef PG8_BAR
#undef PG8_SCHED
}
}

#ifndef PG8_SP2
#define PG8_SP2 true
#endif
#ifndef PG8_ALIGN
#define PG8_ALIGN true
#endif
#include <hip/hip_bf16.h>
#include <cmath>
namespace attn_body {
using bf16=__hip_bfloat16;
using bf16x8=__attribute__((ext_vector_type(8)))short;
using s16x4=__attribute__((ext_vector_type(4)))short;
using f32x16=__attribute__((ext_vector_type(16)))float;
using u32x4=__attribute__((ext_vector_type(4)))unsigned;
constexpr int BATCH=1,NHEAD=32,SEQ=16384,D=64,DM=NHEAD*D;
constexpr int NW=8,QBLK=32,QB=QBLK*NW,KVBLK=64,NQB=SEQ/QB;
constexpr int ATTN_PITCH=DM, ATTN_UNIT_ROWS=QB;
__device__ __forceinline__ int crow(int r,int hi){return (r&3)+8*(r>>2)+4*hi;}
#define SBAR() __builtin_amdgcn_sched_barrier(0)
__device__ __forceinline__ void cmask(f32x16&p0,f32x16&p1,int jb,int qrel,int hi){
  const float NEG=-INFINITY; int kb=64*jb+4*hi;
  #pragma unroll
  for(int r=0;r<16;++r){int kv=kb+(r&3)+8*(r>>2); if(kv>qrel)p0[r]=NEG; if(kv+32>qrel)p1[r]=NEG;}
}

constexpr int NSLOT=3, SLOTB=8192;
constexpr int LDS_K=0, LDS_V=NSLOT*SLOTB, LDS_WS=2*NSLOT*SLOTB, LDS_OST=LDS_WS+NW*64*4, LDS_BYTES=LDS_OST+NW*4096;
constexpr float C2=0.125f*1.4426950408889634f;
__device__ __forceinline__ void glds16(const void*gsrc,unsigned lds_dst){unsigned keep;
  asm volatile("s_mov_b32 %0, m0\n\ts_mov_b32 m0, %2\n\ts_nop 0\n\tglobal_load_lds_dwordx4 %1, off\n\ts_mov_b32 m0, %0":"=&s"(keep):"v"(gsrc),"s"(lds_dst):"memory");}
__device__ __forceinline__ float max3f(float a,float b,float c){float r;asm("v_max3_f32 %0, %1, %2, %3":"=v"(r):"v"(a),"v"(b),"v"(c));return r;}
__device__ __forceinline__ float max2f(float a,float b){float r;asm("v_max_f32_e32 %0, %1, %2":"=v"(r):"v"(a),"v"(b));return r;}
__device__ __forceinline__ float fadd_s(float a,float b){float r;asm("v_add_f32_e32 %0, %1, %2":"=v"(r):"v"(a),"v"(b));return r;}
__device__ __forceinline__ float fsub_s(float a,float b){float r;asm("v_sub_f32_e32 %0, %1, %2":"=v"(r):"v"(a),"v"(b));return r;}
typedef float f32x2_t __attribute__((ext_vector_type(2))); typedef __bf16 bf16x2_t __attribute__((ext_vector_type(2)));
__device__ __forceinline__ unsigned cvtpk_s(float lo,float hi){f32x2_t v={lo,hi};bf16x2_t b=__builtin_convertvector(v,bf16x2_t);return __builtin_bit_cast(unsigned,b);}
#define WAIT_BAR(N) asm volatile("s_waitcnt vmcnt(" #N ") lgkmcnt(0)\n\ts_barrier":::"memory")

__device__ __forceinline__ void qkt(f32x16&p0,f32x16&p1,const char*Kslot,const bf16x8*qr,const f32x16&negm,int r32,int hi){
  const char*kb=Kslot+hi*1024+r32*16;
  #pragma unroll
  for(int d0=0;d0<4;++d0){
    const bf16x8 b0=*reinterpret_cast<const bf16x8*>(kb+d0*2048);
    const bf16x8 b1=*reinterpret_cast<const bf16x8*>(kb+d0*2048+512);
    if(d0==0){p0=__builtin_amdgcn_mfma_f32_32x32x16_bf16(b0,qr[0],negm,0,0,0);p1=__builtin_amdgcn_mfma_f32_32x32x16_bf16(b1,qr[0],negm,0,0,0);}
    else{p0=__builtin_amdgcn_mfma_f32_32x32x16_bf16(b0,qr[d0],p0,0,0,0);p1=__builtin_amdgcn_mfma_f32_32x32x16_bf16(b1,qr[d0],p1,0,0,0);}}
}
typedef __attribute__((address_space(3))) const char* lds_cptr;
typedef short v4i16_t __attribute__((ext_vector_type(4)));
__device__ __forceinline__ void kload8(bf16x8*kf,lds_cptr kp){
  kf[0]=*(const __attribute__((address_space(3))) bf16x8*)(kp);      kf[1]=*(const __attribute__((address_space(3))) bf16x8*)(kp+512);
  kf[2]=*(const __attribute__((address_space(3))) bf16x8*)(kp+2048); kf[3]=*(const __attribute__((address_space(3))) bf16x8*)(kp+2560);
  kf[4]=*(const __attribute__((address_space(3))) bf16x8*)(kp+4096); kf[5]=*(const __attribute__((address_space(3))) bf16x8*)(kp+4608);
  kf[6]=*(const __attribute__((address_space(3))) bf16x8*)(kp+6144); kf[7]=*(const __attribute__((address_space(3))) bf16x8*)(kp+6656);
}
__device__ __forceinline__ void kload2(bf16x8*kf,lds_cptr kp,int j){ kf[2*j]=*(const __attribute__((address_space(3))) bf16x8*)(kp+j*2048); kf[2*j+1]=*(const __attribute__((address_space(3))) bf16x8*)(kp+j*2048+512); }
__device__ __forceinline__ s16x4 vtr(lds_cptr p){ return __builtin_bit_cast(s16x4,__builtin_amdgcn_ds_read_tr16_b64_v4i16((__attribute__((address_space(3))) v4i16_t*)p)); }
__device__ __forceinline__ float rowmax(const f32x16&p0,const f32x16&p1){
  float a=max3f(p0[0],p0[1],p1[0]),b=max3f(p0[2],p0[3],p1[1]);a=max3f(a,p1[2],p1[3]);
  #pragma unroll
  for(int r=4;r<16;r+=4){a=max3f(a,p0[r],p0[r+1]);b=max3f(b,p0[r+2],p0[r+3]);a=max3f(a,p1[r],p1[r+1]);b=max3f(b,p1[r+2],p1[r+3]);}
  const float m=max2f(a,b);
  auto rr=__builtin_amdgcn_permlane32_swap(__float_as_uint(m),__float_as_uint(m),false,false);
  return max2f(__uint_as_float(rr[0]),__uint_as_float(rr[1]));
}
__device__ __forceinline__ void pv(f32x16*o,int vb,bf16x8 pa0,bf16x8 pa1,bf16x8 pa2,bf16x8 pa3){
  #pragma unroll
  for(int d0=0;d0<2;++d0){s16x4 lo[4],hi[4];
    #pragma unroll
    for(int ks=0;ks<4;++ks){
      asm volatile("ds_read_b64_tr_b16 %0,%1 offset:%c2":"=&v"(lo[ks]):"v"(vb),"i"(d0*4096+ks*1024):"memory");
      asm volatile("ds_read_b64_tr_b16 %0,%1 offset:%c2":"=&v"(hi[ks]):"v"(vb),"i"(d0*4096+ks*1024+512):"memory");}
    asm volatile("s_waitcnt lgkmcnt(0)":::"memory");SBAR();
    #define PK(k) (bf16x8){lo[k][0],lo[k][1],lo[k][2],lo[k][3],hi[k][0],hi[k][1],hi[k][2],hi[k][3]}
    o[d0]=__builtin_amdgcn_mfma_f32_32x32x16_bf16(pa0,PK(0),o[d0],0,0,0);
    o[d0]=__builtin_amdgcn_mfma_f32_32x32x16_bf16(pa1,PK(1),o[d0],0,0,0);
    o[d0]=__builtin_amdgcn_mfma_f32_32x32x16_bf16(pa2,PK(2),o[d0],0,0,0);
    o[d0]=__builtin_amdgcn_mfma_f32_32x32x16_bf16(pa3,PK(3),o[d0],0,0,0);
    #undef PK
  }
}

#ifndef ATTN_STORE16
#define ATTN_STORE16(p,v) (*(u32x4*)(p)=(v))
#endif
template<int THRL> __device__ __forceinline__ void attn_unit(int qh,int vh,int qb,const bf16*Q,const bf16*__restrict__ K,const bf16*__restrict__ V,bf16*O,char*shm){
  int tid_=threadIdx.x; asm volatile("":"+v"(tid_));
  const int tid=tid_,lane=tid&63,r32=lane&31,hi=lane>>5; const int wid=__builtin_amdgcn_readfirstlane(tid>>6);
  const long rowbase=0; const int q0=qb*QB;
  const bf16*Qw=Q+(rowbase+q0+wid*QBLK)*DM+qh*D;
  const bf16*Kh=K+rowbase*DM+qh*D,*Vh=V+rowbase*DM+vh*D;
  const unsigned lds0=(unsigned)(uintptr_t)shm;
  float*wsf=(float*)(shm+LDS_WS)+wid*64;
  const bf16*ksrc=Kh+(long)lane*DM+wid*8;
  const bf16*vsrc=Vh+(long)(16*(wid&3)+(lane>>2))*DM+(wid>>2)*32+(lane&3)*8;
  const unsigned kdst=lds0+LDS_K+wid*1024, vdst=lds0+LDS_V+wid*1024;
  #define DMA_K(t,slot) glds16(ksrc+(long)(t)*KVBLK*DM,(unsigned)__builtin_amdgcn_readfirstlane(kdst+(slot)))
  #define DMA_V(t,slot) glds16(vsrc+(long)(t)*KVBLK*DM,(unsigned)__builtin_amdgcn_readfirstlane(vdst+(slot)))
  const int vb0=(int)(lds0+LDS_V)+((lane>>4)&1)*32+(lane&3)*8+(4*hi+((lane&15)>>2))*64;
  const char*Kbase=shm+LDS_K; bf16x8 kf[8];
  const lds_cptr shm3=(lds_cptr)shm; const lds_cptr kp0=shm3+LDS_K+hi*1024+r32*16; const lds_cptr vp0=shm3+LDS_V+((lane>>4)&1)*32+(lane&3)*8+(4*hi+((lane&15)>>2))*64;
  const int NT=(q0+QB)/KVBLK;
  DMA_K(0,0);DMA_V(0,0);DMA_K(1,SLOTB);
  bf16x8 qr[4];
  #pragma unroll
  for(int d0=0;d0<4;++d0)qr[d0]=*reinterpret_cast<const bf16x8*>(&Qw[(long)r32*DM+d0*16+hi*8]);
  float mhat=0.f,l_reg=0.f;f32x16 o[2];o[0]=f32x16{};o[1]=f32x16{};f32x16 negm=f32x16{};asm volatile("":"+v"(negm));
  const int qrel=wid*QBLK+r32;
  #define CMASK(P0,P1,t) do{int jb_=(t)-(NT-4); if(jb_>=0)cmask(P0,P1,jb_,qrel,hi);}while(0)
  bool resc=false;
  #define START(P0,P1) do{ const float rm=rowmax(P0,P1); resc=false; \
    { const float dl=rm; mhat=fadd_s(mhat,dl); \
      _Pragma("unroll") for(int r=0;r<16;++r){P0[r]=fsub_s(P0[r],dl);P1[r]=fsub_s(P1[r],dl);} \
      _Pragma("unroll") for(int r=0;r<16;++r)negm[r]=-mhat; asm volatile("":"+v"(negm)); } \
    _Pragma("unroll") for(int r=0;r<16;++r)P0[r]=__builtin_amdgcn_exp2f(P0[r]); }while(0)
  #define RESC() do{ if(resc){ asm volatile("s_waitcnt lgkmcnt(0)":::"memory"); \
      _Pragma("unroll") for(int d_=0;d_<2;++d_) _Pragma("unroll") for(int r=0;r<16;++r)o[d_][r]*=wsf[crow(r,hi)]; } }while(0)
  f32x16 pA0,pA1,pB0,pB1;
  int sl_prev=0,sl_cur=0,sl_next=SLOTB;
  #define ROT() do{sl_prev=sl_cur;sl_cur=sl_next;sl_next=(sl_next==(NSLOT-1)*SLOTB)?0:sl_next+SLOTB;}while(0)
  DMA_K(2,2*SLOTB);
  WAIT_BAR(3);
  qkt(pA0,pA1,Kbase,qr,negm,r32,hi);asm volatile("s_nop 15\n\ts_nop 7":"+v"(pA0),"+v"(pA1));CMASK(pA0,pA1,0);
  START(pA0,pA1);
  _Pragma("unroll") for(int r=0;r<16;++r)pA1[r]=__builtin_amdgcn_exp2f(pA1[r]);
  WAIT_BAR(0);
  DMA_K(3,0);DMA_V(1,SLOTB);
  ROT();
  kload8(kf,kp0+sl_cur);
  WAIT_BAR(2);
  s16x4 vlo[8],vhi[8]; u32x4 pw0,pw1,pw2,pw3;
  #define PKW(P,B) cvtpk_s(P[B],P[B+1])
  #define PAF(k) __builtin_bit_cast(bf16x8,pw##k)
  #define VFR(i) (bf16x8){vlo[i][0],vlo[i][1],vlo[i][2],vlo[i][3],vhi[i][0],vhi[i][1],vhi[i][2],vhi[i][3]}
  #define PIN(x) asm volatile("":"+v"(x))
  #define MX3(a,b,c) __builtin_fmaxf(__builtin_fmaxf((a),(b)),(c))
  #define GAPA(MF,A0,A1,A2,A3,W0,W1,PW) do{ MF; sacc+=A0; sacc+=A1; sacc+=A2; sacc+=A3; PIN(sacc); W0; W1; PIN(PW); SBAR(); }while(0)
  #define EX(v) __builtin_amdgcn_exp2f(v)
  #define GAPB(MF,X,B) do{ MF; X[B]=EX(X[B]); X[B+1]=EX(X[B+1]); X[B+2]=EX(X[B+2]); X[B+3]=EX(X[B+3]); PIN(X); SBAR(); }while(0)
  #define VRD(i) do{ vlo[i]=vtr(vp_+(((i)>>2)*4096+((i)&3)*1024)); vhi[i]=vtr(vp_+(((i)>>2)*4096+((i)&3)*1024+512)); }while(0)
  #define KRD(G,j) do{ if(G){ kload2(kf,kp0+sl_next,j); SBAR(); } }while(0)
  #define STEP(C0,C1,P0,P1,t,GK,GV,GL) do{ SBAR(); \
    const lds_cptr vp_=vp0+sl_prev; \
    VRD(0); SBAR(); float sacc=(P0[0]+P0[1]); \
    GAPA(C0=__builtin_amdgcn_mfma_f32_32x32x16_bf16(kf[0],qr[0],negm,0,0,0), P0[2],P0[3],P0[4],P0[5],     pw0[0]=PKW(P0,0), pw0[1]=PKW(P0,2), pw0); \
    VRD(4); SBAR(); GAPA(C1=__builtin_amdgcn_mfma_f32_32x32x16_bf16(kf[1],qr[0],negm,0,0,0), P0[6],P0[7],P0[8],P0[9],     pw0[2]=PKW(P0,4), pw0[3]=PKW(P0,6), pw0); \
    VRD(1); SBAR(); GAPA(C0=__builtin_amdgcn_mfma_f32_32x32x16_bf16(kf[2],qr[1],C0,0,0,0),   P0[10],P0[11],P0[12],P0[13], pw1[0]=PKW(P0,8), pw1[1]=PKW(P0,10), pw1); \
    VRD(5); SBAR(); GAPA(C1=__builtin_amdgcn_mfma_f32_32x32x16_bf16(kf[3],qr[1],C1,0,0,0),   P0[14],P0[15],P1[0],P1[1],   pw1[2]=PKW(P0,12),pw1[3]=PKW(P0,14), pw1); \
    VRD(2); SBAR(); GAPA(C0=__builtin_amdgcn_mfma_f32_32x32x16_bf16(kf[4],qr[2],C0,0,0,0),   P1[2],P1[3],P1[4],P1[5],     pw2[0]=PKW(P1,0), pw2[1]=PKW(P1,2), pw2); \
    VRD(6); SBAR(); GAPA(C1=__builtin_amdgcn_mfma_f32_32x32x16_bf16(kf[5],qr[2],C1,0,0,0),   P1[6],P1[7],P1[8],P1[9],     pw2[2]=PKW(P1,4), pw2[3]=PKW(P1,6), pw2); \
    VRD(3); SBAR(); GAPA(C0=__builtin_amdgcn_mfma_f32_32x32x16_bf16(kf[6],qr[3],C0,0,0,0),   P1[10],P1[11],P1[12],P1[13], pw3[0]=PKW(P1,8), pw3[1]=PKW(P1,10), pw3); \
    VRD(7); SBAR(); GAPA(C1=__builtin_amdgcn_mfma_f32_32x32x16_bf16(kf[7],qr[3],C1,0,0,0),   P1[14],P1[15],0.f,0.f,       pw3[2]=PKW(P1,12),pw3[3]=PKW(P1,14), pw3); \
    l_reg+=sacc; \
    if(GK){DMA_K((t)+3,sl_cur);} if(GV){DMA_V((t)+1,sl_next);} \
    CMASK(C0,C1,t); \
    { float a=MX3(C0[0],C0[1],C1[0]),b=MX3(C0[2],C0[3],C1[1]); a=MX3(a,C1[2],C1[3]); \
      _Pragma("unroll") for(int r=4;r<16;r+=4){a=MX3(a,C0[r],C0[r+1]);b=MX3(b,C0[r+2],C0[r+3]);a=MX3(a,C1[r],C1[r+1]);b=MX3(b,C1[r+2],C1[r+3]);} \
      float rm=__builtin_fmaxf(a,b); { auto rr=__builtin_amdgcn_permlane32_swap(__float_as_uint(rm),__float_as_uint(rm),false,false); rm=__builtin_fmaxf(__uint_as_float(rr[0]),__uint_as_float(rr[1])); } \
      resc=false; \
      if(__builtin_expect(__any(rm>(float)THRL),0)){ const float dl=__builtin_fmaxf(rm,0.f); mhat+=dl; \
        _Pragma("unroll") for(int r=0;r<16;++r){C0[r]-=dl;C1[r]-=dl;} \
        _Pragma("unroll") for(int r=0;r<16;++r)negm[r]=-mhat; asm volatile("":"+v"(negm)); \
        const float f=__builtin_amdgcn_exp2f(-dl); l_reg*=f; if(hi==0)wsf[r32]=f; resc=true; } } \
    SBAR(); \
    GAPB(o[0]=__builtin_amdgcn_mfma_f32_32x32x16_bf16(PAF(0),VFR(0),o[0],0,0,0), C0,0); \
    GAPB(o[1]=__builtin_amdgcn_mfma_f32_32x32x16_bf16(PAF(0),VFR(4),o[1],0,0,0), C0,4); \
    KRD(GL,0); GAPB(o[0]=__builtin_amdgcn_mfma_f32_32x32x16_bf16(PAF(1),VFR(1),o[0],0,0,0), C0,8); \
    KRD(GL,1); GAPB(o[1]=__builtin_amdgcn_mfma_f32_32x32x16_bf16(PAF(1),VFR(5),o[1],0,0,0), C0,12); \
    KRD(GL,2); GAPB(o[0]=__builtin_amdgcn_mfma_f32_32x32x16_bf16(PAF(2),VFR(2),o[0],0,0,0), C1,0); \
    KRD(GL,3); GAPB(o[1]=__builtin_amdgcn_mfma_f32_32x32x16_bf16(PAF(2),VFR(6),o[1],0,0,0), C1,4); \
    GAPB(o[0]=__builtin_amdgcn_mfma_f32_32x32x16_bf16(PAF(3),VFR(3),o[0],0,0,0), C1,8); \
    GAPB(o[1]=__builtin_amdgcn_mfma_f32_32x32x16_bf16(PAF(3),VFR(7),o[1],0,0,0), C1,12); \
    }while(0)
  int t=1;
  #undef CMASK
  #define CMASK(P0,P1,t) do{}while(0)
  for(;t+5<NT;t+=2){
    STEP(pB0,pB1,pA0,pA1,t,true,true,true);     WAIT_BAR(2); RESC(); ROT();
    STEP(pA0,pA1,pB0,pB1,t+1,true,true,true);   WAIT_BAR(2); RESC(); ROT();
  }
  #undef CMASK
  #define CMASK(P0,P1,t) do{int jb_=(t)-(NT-4); if(jb_>=0)cmask(P0,P1,jb_,qrel,hi);}while(0)
  #define ENDW(tt) do{ if((tt)+3<NT){WAIT_BAR(2);} else if((tt)+2<NT){WAIT_BAR(1);} else {WAIT_BAR(0);} }while(0)
  for(;t+1<NT;t+=2){
    STEP(pB0,pB1,pA0,pA1,t,(t+3<NT),(t+1<NT),(t+1<NT));       ENDW(t);   RESC(); ROT();
    STEP(pA0,pA1,pB0,pB1,t+1,(t+4<NT),(t+2<NT),(t+2<NT));     ENDW(t+1); RESC(); ROT();
  }
  STEP(pB0,pB1,pA0,pA1,NT-1,false,false,false); RESC();
  { float sacc=pB0[0]+pB0[1]; _Pragma("unroll") for(int r=2;r<16;++r)sacc+=pB0[r]; _Pragma("unroll") for(int r=0;r<16;++r)sacc+=pB1[r]; l_reg+=sacc;
    pw0=(u32x4){PKW(pB0,0),PKW(pB0,2),PKW(pB0,4),PKW(pB0,6)};pw1=(u32x4){PKW(pB0,8),PKW(pB0,10),PKW(pB0,12),PKW(pB0,14)};pw2=(u32x4){PKW(pB1,0),PKW(pB1,2),PKW(pB1,4),PKW(pB1,6)};pw3=(u32x4){PKW(pB1,8),PKW(pB1,10),PKW(pB1,12),PKW(pB1,14)};
    SBAR(); pv(o,vb0+sl_cur,PAF(0),PAF(1),PAF(2),PAF(3)); }
  #undef PKW
  #undef PAF
  #undef VFR
  #undef PIN
  #undef MX3
  #undef GAPA
  #undef GAPB
  #undef EX
  #undef VRD
  #undef KRD
  #undef STEP
  #undef ENDW
  {auto rr=__builtin_amdgcn_permlane32_swap(__float_as_uint(l_reg),__float_as_uint(l_reg),false,false);l_reg=__uint_as_float(rr[0])+__uint_as_float(rr[1]);}
  if(hi==0)wsf[32+r32]=l_reg;asm volatile("s_waitcnt lgkmcnt(0)":::"memory");
  float rli[16];
  #pragma unroll
  for(int r=0;r<16;++r)rli[r]=__builtin_amdgcn_rcpf(wsf[32+crow(r,hi)]);
  bf16*Ow=O+(rowbase+q0+wid*QBLK)*DM+vh*D;
  { bf16*stg=(bf16*)(shm+LDS_OST)+wid*2048;
    #pragma unroll
    for(int r=0;r<16;++r){const int orow=crow(r,hi);
      #pragma unroll
      for(int d0=0;d0<2;++d0)stg[orow*64+d0*32+r32]=__float2bfloat16(o[d0][r]*rli[r]);}
    asm volatile("s_waitcnt lgkmcnt(0)":::"memory");
    #pragma unroll
    for(int i=0;i<4;++i){const int row=i*8+(lane>>3),ch=lane&7; const u32x4 v=*(const u32x4*)(stg+row*64+ch*8); ATTN_STORE16(Ow+(long)row*DM+ch*8,v);} }
  asm volatile("s_waitcnt lgkmcnt(0)\n\ts_barrier":::"memory");
  #undef DMA_K
  #undef DMA_V
  #undef CMASK
  #undef START
  #undef RESC
  #undef ROT
}
constexpr int ATTN_LDS_BYTES=LDS_BYTES;
struct AttnTensors { const bf16* Q; const bf16* K; const bf16* V; bf16* O0; bf16* O1; };
struct AttnUnit { int vv; int qb; };
struct StaticOrder {
  int x, j;
  __device__ __forceinline__ explicit StaticOrder(int vcu):x(vcu>>5),j(vcu&31){}
  __device__ __forceinline__ bool next(int i,AttnUnit&u)const{ if(i>=16)return false; u.vv=x*8+(i>>1); u.qb=(i&1)?63-j:j; return true; }
  __device__ __forceinline__ void a_ready(const AttnUnit&)const{}
  __device__ __forceinline__ void done(const AttnUnit&)const{}
};
template<class Sched,int THRL=8> __device__ __forceinline__ void attn_phase(char*lds,const AttnTensors&T,const Sched&S){
  AttnUnit u;
  for(int i=0;S.next(i,u);++i){ S.a_ready(u); const int h=u.vv>>2,c=(u.vv>>1)&1,jv=u.vv&1; attn_unit<THRL>(2*h+c,2*h+jv,u.qb,T.Q,T.K,T.V,c?T.O1:T.O0,lds); S.done(u); }
}
#undef SBAR
#undef WAIT_BAR
}
namespace da {
using attn_body::bf16; using attn_body::bf16x8; using attn_body::s16x4; using attn_body::f32x16; using attn_body::u32x4;
typedef __attribute__((address_space(3))) const char* lds_cptr;
typedef __attribute__((address_space(3))) char* lds_ptr;
constexpr int SEQ = 16384, PITCH = 2048, QBR = 128, KVB = 64;
constexpr int KSLOT = 16384, VSLOT = 16384, NKS = 3, NVS = 4, LDS_K = 0, LDS_V = NKS * KSLOT, LDS_WS = LDS_V + NVS * VSLOT, LDS_END = LDS_WS + 8 * 256;
constexpr int EP_ROWB = 528, EP_TILE = 32 * EP_ROWB;
static_assert(4 * EP_TILE <= LDS_WS && LDS_END <= 131072, "da LDS map");
__device__ __forceinline__ int crow(int r, int hi) { return (r & 3) + 8 * (r >> 2) + 4 * hi; }
#define DA_WAIT_BAR(N) asm volatile("s_waitcnt vmcnt(" #N ")\n\ts_barrier" ::: "memory")
#define DA_BAR() asm volatile("s_waitcnt lgkmcnt(0)\n\ts_barrier" ::: "memory")
struct Tensors { const bf16* Q; const bf16* K; const bf16* V; bf16* ON; const float* subg; float lam, post, mb; };

template <bool SHIFT> __device__ __forceinline__ void unit(const Tensors& TT, int h, int qb, char* shm) {
    int tid_ = threadIdx.x; asm volatile("" : "+v"(tid_));
    const int tid = tid_, lane = tid & 63, r32 = lane & 31, hi = lane >> 5; const int wid = __builtin_amdgcn_readfirstlane(tid >> 6);
    const int c = wid >> 2, rg = wid & 3;
    const int q0 = qb * QBR, NT = (q0 + QBR) / KVB;
    const unsigned lds0 = (unsigned)(uintptr_t)shm;
    const lds_cptr shm3 = (lds_cptr)shm;
    const int krow = 8 * wid + (lane >> 3), vrow = 8 * wid + (lane >> 4);
    const bf16* ksrc0 = TT.K + ((long)(2 * h) * SEQ + krow) * 64 + (((lane & 7) ^ ((krow >> 1) & 7)) * 8);
    const bf16* ksrc1 = ksrc0 + (long)SEQ * 64;
    const bf16* vsrcA = TT.V + ((long)h * SEQ + vrow) * 128 + (((lane & 15) ^ (4 * (vrow & 3))) * 8);
    const bf16* vsrcB = vsrcA + 4 * 128;
    const unsigned kdst = lds0 + LDS_K + wid * 1024, vdst = lds0 + LDS_V + wid * 2048;
#define DA_DMA(t, ksl, vsl) do { const long to_ = (long)(t) * KVB * 64; \
        attn_body::glds16(ksrc0 + to_, (unsigned)__builtin_amdgcn_readfirstlane(kdst + (ksl) * KSLOT)); attn_body::glds16(ksrc1 + to_, (unsigned)__builtin_amdgcn_readfirstlane(kdst + (ksl) * KSLOT + 8192)); \
        attn_body::glds16(vsrcA + 2 * to_, (unsigned)__builtin_amdgcn_readfirstlane(vdst + (vsl) * VSLOT)); attn_body::glds16(vsrcB + 2 * to_, (unsigned)__builtin_amdgcn_readfirstlane(vdst + (vsl) * VSLOT + 1024)); } while (0)
    const bf16* Qw = TT.Q + ((long)(2 * h + c) * SEQ + q0 + rg * 32) * 64;
    bf16x8 qr[4];
#pragma unroll
    for (int d0 = 0; d0 < 4; ++d0) qr[d0] = *reinterpret_cast<const bf16x8*>(&Qw[r32 * 64 + d0 * 16 + hi * 8]);
    DA_DMA(0, 0, 0); DA_DMA(1, 1, 1);
    f32x16 negm = f32x16{};
    if constexpr (SHIFT) { const float nm = -TT.mb;
#pragma unroll
        for (int r = 0; r < 16; ++r) negm[r] = nm;
        asm volatile("" : "+v"(negm)); }
    f32x16 o[4]; o[0] = f32x16{}; o[1] = f32x16{}; o[2] = f32x16{}; o[3] = f32x16{};
    typedef float f32x2_t __attribute__((ext_vector_type(2)));
    f32x2_t lA = {0.f, 0.f}, lB = {0.f, 0.f};
    const int qrel = rg * 32 + r32;
    const int ksw = (r32 >> 1) & 7;
    const lds_cptr kp0 = shm3 + LDS_K + c * 8192 + r32 * 128;
    const int kof0 = ((0 + hi) ^ ksw) * 16, kof1 = ((2 + hi) ^ ksw) * 16, kof2 = ((4 + hi) ^ ksw) * 16, kof3 = ((6 + hi) ^ ksw) * 16;
    const int vq = (lane & 15) >> 2;
    const int vb0 = (int)(lds0 + LDS_V) + (4 * hi + vq) * 256 + ((lane >> 4) & 1) * 32 + (lane & 3) * 8;
    s16x4 vl[2][4], vh[2][4];
#define DA_VRD(db, vb_) do { _Pragma("unroll") for (int ks_ = 0; ks_ < 4; ++ks_) { \
            asm volatile("ds_read_b64_tr_b16 %0,%1 offset:%c2" : "=&v"(vl[(db) & 1][ks_]) : "v"(vb_ + (((db) ^ vq) * 64)), "i"(ks_ * 4096) : "memory"); \
            asm volatile("ds_read_b64_tr_b16 %0,%1 offset:%c2" : "=&v"(vh[(db) & 1][ks_]) : "v"(vb_ + (((db) ^ vq) * 64)), "i"(ks_ * 4096 + 2048) : "memory"); } } while (0)
#define DA_PVMM(db) do { __builtin_amdgcn_sched_barrier(0); _Pragma("unroll") for (int ks_ = 0; ks_ < 4; ++ks_) { \
            const bf16x8 vf_ = (bf16x8){vl[(db) & 1][ks_][0], vl[(db) & 1][ks_][1], vl[(db) & 1][ks_][2], vl[(db) & 1][ks_][3], vh[(db) & 1][ks_][0], vh[(db) & 1][ks_][1], vh[(db) & 1][ks_][2], vh[(db) & 1][ks_][3]}; \
            o[db] = __builtin_amdgcn_mfma_f32_32x32x16_bf16(__builtin_bit_cast(bf16x8, pw[ks_]), vf_, o[db], 0, 0, 0); } __builtin_amdgcn_sched_barrier(0); } while (0)
#define DA_PV_REST(vb_) do { asm volatile("s_waitcnt lgkmcnt(8)" ::: "memory"); DA_PVMM(0); DA_VRD(2, vb_); asm volatile("s_waitcnt lgkmcnt(8)" ::: "memory"); DA_PVMM(1); DA_VRD(3, vb_); \
        asm volatile("s_waitcnt lgkmcnt(8)" ::: "memory"); DA_PVMM(2); asm volatile("s_waitcnt lgkmcnt(0)" ::: "memory"); DA_PVMM(3); } while (0)
    u32x4 pw[4];
    int ksl = 0, vsl = 0;
#define DA_PVX1(db, ks_) do { const bf16x8 vf_ = (bf16x8){vl[(db) & 1][ks_][0], vl[(db) & 1][ks_][1], vl[(db) & 1][ks_][2], vl[(db) & 1][ks_][3], vh[(db) & 1][ks_][0], vh[(db) & 1][ks_][1], vh[(db) & 1][ks_][2], vh[(db) & 1][ks_][3]}; \
            o[db] = __builtin_amdgcn_mfma_f32_32x32x16_bf16(__builtin_bit_cast(bf16x8, pw[ks_]), vf_, o[db], 0, 0, 0); \
            p0[4 * (db) + ks_] = __builtin_amdgcn_exp2f(p0[4 * (db) + ks_]); p1[4 * (db) + ks_] = __builtin_amdgcn_exp2f(p1[4 * (db) + ks_]); asm volatile("" : "+v"(p0), "+v"(p1)); __builtin_amdgcn_sched_barrier(0); } while (0)
#define DA_PVX(db) do { __builtin_amdgcn_sched_barrier(0); DA_PVX1(db, 0); DA_PVX1(db, 1); DA_PVX1(db, 2); DA_PVX1(db, 3); } while (0)
    for (int t = 0; t < NT; ++t) {
        if (t + 1 < NT) { DA_WAIT_BAR(4); } else { DA_WAIT_BAR(0); }
        const lds_cptr kp = kp0 + ksl * KSLOT;
        bf16x8 kf[8];
#pragma unroll
        for (int d0 = 0; d0 < 4; ++d0) { const int ko = (d0 == 0) ? kof0 : (d0 == 1) ? kof1 : (d0 == 2) ? kof2 : kof3;
            kf[2 * d0] = *(const __attribute__((address_space(3))) bf16x8*)(kp + ko); kf[2 * d0 + 1] = *(const __attribute__((address_space(3))) bf16x8*)(kp + ko + 4096); }
        f32x16 p0, p1;
        p0 = __builtin_amdgcn_mfma_f32_32x32x16_bf16(kf[0], qr[0], negm, 0, 0, 0); p1 = __builtin_amdgcn_mfma_f32_32x32x16_bf16(kf[1], qr[0], negm, 0, 0, 0);
#pragma unroll
        for (int d0 = 1; d0 < 4; ++d0) { p0 = __builtin_amdgcn_mfma_f32_32x32x16_bf16(kf[2 * d0], qr[d0], p0, 0, 0, 0); p1 = __builtin_amdgcn_mfma_f32_32x32x16_bf16(kf[2 * d0 + 1], qr[d0], p1, 0, 0, 0); }
        if (t + 2 < NT) { DA_DMA(t + 2, (ksl >= 1) ? ksl - 1 : 2, (vsl + 2) & 3); }
        if (t >= NT - 2) {
            const int kb = 64 * (t - (NT - 2)) + 4 * hi;
#pragma unroll
            for (int r = 0; r < 16; ++r) { const int kv = kb + (r & 3) + 8 * (r >> 2); if (kv > qrel) p0[r] = -INFINITY; if (kv + 32 > qrel) p1[r] = -INFINITY; }
        }
        if (t > 0) {
            const int vb = vb0 + ((vsl + 3) & 3) * VSLOT;
            asm volatile("s_waitcnt lgkmcnt(8)" ::: "memory"); DA_PVX(0); DA_VRD(2, vb); asm volatile("s_waitcnt lgkmcnt(8)" ::: "memory"); DA_PVX(1); DA_VRD(3, vb);
            asm volatile("s_waitcnt lgkmcnt(8)" ::: "memory"); DA_PVX(2);
            { const int vbc = vb0 + vsl * VSLOT; DA_VRD(0, vbc); }
            asm volatile("s_waitcnt lgkmcnt(8)" ::: "memory"); DA_PVX(3);
        } else {
#pragma unroll
            for (int r = 0; r < 16; ++r) { p0[r] = __builtin_amdgcn_exp2f(p0[r]); p1[r] = __builtin_amdgcn_exp2f(p1[r]); }
        }
        { const int vbc = vb0 + vsl * VSLOT; if (t == 0) { asm volatile("s_waitcnt lgkmcnt(0)" ::: "memory"); DA_VRD(0, vbc); } DA_VRD(1, vbc); }
        __builtin_amdgcn_sched_barrier(0);
#pragma unroll
        for (int i = 0; i < 8; ++i) { lA += (f32x2_t){p0[2 * i], p0[2 * i + 1]}; lB += (f32x2_t){p1[2 * i], p1[2 * i + 1]}; }
#pragma unroll
        for (int e = 0; e < 4; ++e) { pw[0][e] = attn_body::cvtpk_s(p0[2 * e], p0[2 * e + 1]); pw[1][e] = attn_body::cvtpk_s(p0[8 + 2 * e], p0[9 + 2 * e]);
            pw[2][e] = attn_body::cvtpk_s(p1[2 * e], p1[2 * e + 1]); pw[3][e] = attn_body::cvtpk_s(p1[8 + 2 * e], p1[9 + 2 * e]); }
        ksl = (ksl == 2) ? 0 : ksl + 1; vsl = (vsl + 1) & 3;
    }
    { const int vb = vb0 + ((vsl + 3) & 3) * VSLOT; DA_PV_REST(vb); }
#undef DA_PVX1
#undef DA_PVX
#undef DA_VRD
#undef DA_PVMM
#undef DA_PV_REST
#undef DA_DMA
    float l_reg = (lA.x + lA.y) + (lB.x + lB.y);
    { auto rr = __builtin_amdgcn_permlane32_swap(__float_as_uint(l_reg), __float_as_uint(l_reg), false, false); l_reg = __uint_as_float(rr[0]) + __uint_as_float(rr[1]); }
    float* wsf = (float*)(shm + LDS_WS) + wid * 64;
    if (hi == 0) wsf[r32] = l_reg;
    asm volatile("s_waitcnt lgkmcnt(0)" ::: "memory");
    float rli[16];
    const float lsc = c ? TT.lam : 1.0f;
#pragma unroll
    for (int r = 0; r < 16; ++r) rli[r] = lsc * __builtin_amdgcn_rcpf(wsf[crow(r, hi)]);
#pragma unroll
    for (int db = 0; db < 4; ++db)
#pragma unroll
        for (int r = 0; r < 16; ++r) o[db][r] *= rli[r];
    DA_BAR();
    float* nat = (float*)shm + rg * 4096 + lane;
    if (c == 1) {
#pragma unroll
        for (int db = 0; db < 4; ++db)
#pragma unroll
            for (int r = 0; r < 16; ++r) nat[(db * 16 + r) * 64] = o[db][r];
    }
    DA_BAR();
    if (c == 0) {
#pragma unroll
        for (int db = 0; db < 4; ++db)
#pragma unroll
            for (int r = 0; r < 16; ++r) o[db][r] -= nat[(db * 16 + r) * 64];
    }
    DA_BAR();
    if (c == 0) {
        char* rt = shm + rg * EP_TILE + r32 * 4;
#pragma unroll
        for (int db = 0; db < 4; ++db)
#pragma unroll
            for (int r = 0; r < 16; ++r) *(float*)(rt + crow(r, hi) * EP_ROWB + db * 128) = o[db][r];
    }
    DA_BAR();
    {
        const int row = tid >> 2, qt = tid & 3;
        const char* rp = shm + (row >> 5) * EP_TILE + (row & 31) * EP_ROWB + qt * 128;
        typedef float f32x4_t __attribute__((ext_vector_type(4)));
        f32x4_t v[8]; float ss = 0.f;
#pragma unroll
        for (int i = 0; i < 8; ++i) { v[i] = *(const f32x4_t*)(rp + 16 * i); ss += (v[i][0] * v[i][0] + v[i][1] * v[i][1]) + (v[i][2] * v[i][2] + v[i][3] * v[i][3]); }
        ss += __shfl_xor(ss, 1); ss += __shfl_xor(ss, 2);
        const float rs = TT.post / sqrtf(ss * (1.0f / 128.0f) + 1e-6f);
        const f32x4_t* gp = (const f32x4_t*)(TT.subg + qt * 32);
        bf16* op = TT.ON + (long)(q0 + row) * PITCH + h * 128 + qt * 32;
#pragma unroll
        for (int i = 0; i < 4; ++i) { const f32x4_t a = v[2 * i] * gp[2 * i] * rs, b = v[2 * i + 1] * gp[2 * i + 1] * rs; u32x4 w;
            w[0] = attn_body::cvtpk_s(a[0], a[1]); w[1] = attn_body::cvtpk_s(a[2], a[3]); w[2] = attn_body::cvtpk_s(b[0], b[1]); w[3] = attn_body::cvtpk_s(b[2], b[3]);
            *(u32x4*)(op + 8 * i) = w; }
    }
    DA_BAR();
}
__device__ __forceinline__ void phase(char* lds, const Tensors& TT, int vcu) {
    const int x = vcu >> 5, j = vcu & 31;
    if (TT.mb > 64.0f) { for (int i = 0; i < 8; ++i) { const int h = 2 * x + (i >> 2), k = i & 3; const int qb = (k == 0) ? 127 - j : (k == 1) ? 64 + j : (k == 2) ? 63 - j : j; unit<true>(TT, h, qb, lds); } }
    else { for (int i = 0; i < 8; ++i) { const int h = 2 * x + (i >> 2), k = i & 3; const int qb = (k == 0) ? 127 - j : (k == 1) ? 64 + j : (k == 2) ? 63 - j : j; unit<false>(TT, h, qb, lds); } }
}
#undef DA_WAIT_BAR
#undef DA_BAR
}
constexpr int NWAVES = 8;
#ifndef EN_MASK
#define EN_MASK 0xffff
#endif
#define EN(k) ((EN_MASK >> (k)) & 1)
#ifndef REP_MASK
#define REP_MASK 0
#endif
#define REP(k) (1 + ((REP_MASK >> (k)) & 1))
#ifndef MK_SPLIT
#define MK_SPLIT 0
#endif
constexpr int T = 16384, D = 2048, FF = 5632, DEPTH = 4, M = T;
constexpr int N_PHASES = 2 * (10 + 11);
constexpr float NORM_EPS = 1e-6f;

constexpr size_t MiB = 1u << 20;
constexpr size_t WS_CTL = 0, CTL_ZERO_BYTES = 1 * MiB;
constexpr size_t WS_SMALL = 1 * MiB;
constexpr size_t WS_ROPE = 2 * MiB;
constexpr size_t WS_RTAB = 4 * MiB;
constexpr size_t WS_W1GU = 32 * MiB, WS_W1D = 76 * MiB, WS_W2GU = 98 * MiB, WS_W2D = 142 * MiB, WS_WMIX = 164 * MiB;
constexpr size_t WS_XN = 228 * MiB;
constexpr size_t WS_ACT = 292 * MiB;
constexpr size_t WS_H = WS_ACT;
constexpr size_t WS_Q = WS_ACT, WS_K = WS_ACT + 64 * MiB, WS_V = WS_ACT + 128 * MiB, WS_O0 = WS_ACT + 192 * MiB, WS_O1 = WS_ACT + 256 * MiB, WS_ON = WS_ACT + 320 * MiB;
constexpr size_t WS_QR = WS_ACT, WS_KR = WS_ACT + 64 * MiB, WS_KZT = WS_ACT + 128 * MiB, WS_VT = WS_ACT + 192 * MiB, WS_GS = WS_ACT + 320 * MiB, WS_RT = WS_ACT + 448 * MiB;
constexpr size_t WS_END = WS_ACT + 704 * MiB;
static_assert(WS_W1GU + (size_t)2 * FF * D * 2 <= WS_W1D && WS_W1D + (size_t)D * FF * 2 <= WS_W2GU && WS_W2GU + (size_t)2 * FF * D * 2 <= WS_W2D && WS_W2D + (size_t)D * FF * 2 <= WS_WMIX && WS_WMIX + 64 * MiB <= WS_XN, "weight map");
static_assert(WS_XN + (size_t)T * D * 2 <= WS_ACT && WS_H + (size_t)T * FF * 2 <= WS_END && WS_RT + (size_t)128 * 8 * 512 * 256 * 2 <= WS_END && WS_KZT + (size_t)2048 * T * 2 <= WS_VT && WS_VT + (size_t)4096 * T * 2 <= WS_GS && WS_GS + (size_t)T * 4096 * 2 <= WS_RT, "activation map");
constexpr int CW_TMO = 0, CW_CODE = 1;
constexpr int CW_BAR = 4096;

constexpr int RING_OFF = 0, RING_BYTES = 131072;
constexpr int LDSCTL_OFF = RING_BYTES, MISC_OFF = LDSCTL_OFF + 320, PTAB_OFF = LDSCTL_OFF + 1024;
constexpr int LDS_BYTES = 147456;
static_assert(MISC_OFF + 128 <= PTAB_OFF && PTAB_OFF + 28 * 8 <= LDS_BYTES, "LDS map");

#define GAS __attribute__((address_space(1)))
#define LAS __attribute__((address_space(3)))
typedef unsigned short bf16;
typedef unsigned v4u __attribute__((ext_vector_type(4)));
typedef float f32x4 __attribute__((ext_vector_type(4)));
typedef short bf16x8 __attribute__((ext_vector_type(8)));
typedef GAS unsigned gu32;
typedef GAS unsigned long long gu64;
#define RLX_AGENT __ATOMIC_RELAXED, __HIP_MEMORY_SCOPE_AGENT
#define LDS_WAIT() asm volatile("s_waitcnt lgkmcnt(0)" ::: "memory")
#define VM_WAIT() asm volatile("s_waitcnt vmcnt(0)" ::: "memory")
__device__ __forceinline__ unsigned long long rt() { return __builtin_amdgcn_s_memrealtime(); }
__device__ __forceinline__ unsigned f2bf(float f) { unsigned u = __builtin_bit_cast(unsigned, f); return (u + 0x7fffu + ((u >> 16) & 1u)) >> 16; }
__device__ __forceinline__ unsigned pk2(float lo, float hi) { unsigned r; asm("v_cvt_pk_bf16_f32 %0, %1, %2" : "=v"(r) : "v"(lo), "v"(hi)); return r; }

#define XB_TMO      128
#define XB_XCNT(j)  (256  + 64 * (j))
#define XB_XSUB(j)  (1280 + 64 * (j))
#define XB_XGEN(j)  (2304 + 64 * (j))
#define XB_TOP      3328
#define XB_TOPGEN   3392
#define XCD_BAR_WORDS 3456
#define XB_SPIN_CAP (1u << 18)

__device__ __forceinline__ unsigned xb_ld(unsigned* p)              { return __hip_atomic_load(p, __ATOMIC_RELAXED, __HIP_MEMORY_SCOPE_AGENT); }
__device__ __forceinline__ unsigned xb_add(unsigned* p, unsigned v) { return __hip_atomic_fetch_add(p, v, __ATOMIC_RELAXED, __HIP_MEMORY_SCOPE_AGENT); }
__device__ __forceinline__ unsigned xb_xcc_id() { return (unsigned)__builtin_amdgcn_s_getreg((3 << 11) | 20) & 0xFu; }
#define XB_SPIN(cond, bar) do { unsigned _sp = 0; while (cond) { __builtin_amdgcn_s_sleep(1); \
    if ((++_sp & 255u) == 0u) { if (xb_ld(&(bar)[XB_TMO])) break; if (_sp > XB_SPIN_CAP) { atomicAdd(&(bar)[XB_TMO], 1u); break; } } } } while (0)

struct XcdBarrier {
    unsigned* bar; unsigned x;
    volatile LAS unsigned* st;
};

__device__ __forceinline__ XcdBarrier xcd_barrier_post(unsigned* bar, volatile LAS unsigned* st) {
    XcdBarrier b; b.bar = bar; b.x = xb_xcc_id(); b.st = st;
    if (threadIdx.x == 0) (void)xb_add(&bar[XB_XCNT(b.x)], 1u);
    return b;
}
__device__ __forceinline__ void xcd_barrier_complete(unsigned* bar, unsigned x, unsigned& nloc, unsigned& nx) {
    const unsigned G = gridDim.x * gridDim.y * gridDim.z;
    unsigned sum, cnt, mine, sp = 0u;
    for (;;) {
        sum = 0u; cnt = 0u; mine = 0u;
#pragma unroll
        for (unsigned j = 0; j < 16; ++j) { const unsigned c = xb_ld(&bar[XB_XCNT(j)]); sum += c; cnt += (c > 0u) ? 1u : 0u; mine = (j == x) ? c : mine; }
        if (sum == G) break;
        __builtin_amdgcn_s_sleep(1);
        if ((++sp & 255u) == 0u) { if (xb_ld(&bar[XB_TMO])) break; if (sp > XB_SPIN_CAP) { atomicAdd(&bar[XB_TMO], 1u); break; } }
    }
    nloc = mine > 0u ? mine : 1u; nx = cnt > 0u ? cnt : 1u;
}

__device__ __forceinline__ void xcd_barrier(const XcdBarrier& b) {
    asm volatile("s_waitcnt vmcnt(0)" ::: "memory");
    __syncthreads();
    if (threadIdx.x == 0) {
        unsigned* bar = b.bar;
        __builtin_amdgcn_s_waitcnt(0);
        unsigned nloc = b.st[0], nx = b.st[1];
        if (nloc == 0u) { xcd_barrier_complete(bar, b.x, nloc, nx); b.st[0] = nloc; b.st[1] = nx; }
        const unsigned old = xb_add(&bar[XB_XSUB(b.x)], 1u);
        const unsigned gen = old / nloc;
        if (old + 1u == (gen + 1u) * nloc) {
            __builtin_amdgcn_fence(__ATOMIC_RELEASE, "agent");
            asm volatile("s_waitcnt vmcnt(0)" ::: "memory");
            const unsigned og = xb_add(&bar[XB_TOP], 1u);
            const unsigned tg = og / nx;
            if (og + 1u == (tg + 1u) * nx) xb_add(&bar[XB_TOPGEN], 1u);
            else XB_SPIN(xb_ld(&bar[XB_TOPGEN]) == tg, bar);
            __builtin_amdgcn_fence(__ATOMIC_ACQUIRE, "agent");
            xb_add(&bar[XB_XGEN(b.x)], 1u);
            asm volatile("s_waitcnt vmcnt(0)" ::: "memory");
        } else {
            XB_SPIN(xb_ld(&bar[XB_XGEN(b.x)]) == gen, bar);
            __builtin_amdgcn_fence(__ATOMIC_ACQUIRE, "agent");
            asm volatile("s_waitcnt vmcnt(0)" ::: "memory");
        }
    }
    __syncthreads();
}

typedef float f32x2 __attribute__((ext_vector_type(2)));

struct Frame {
    LAS unsigned char* lds;
    volatile LAS unsigned* MISC;
    gu32* ctl;
    int tid, lane, wave;
    int vcu, G;
    unsigned char* ws;
};

__device__ __forceinline__ float wave_sum(float v) {
#define WS_DPP(ctrl, rmask) v += __int_as_float(__builtin_amdgcn_update_dpp(0, __float_as_int(v), ctrl, rmask, 0xF, false))
    WS_DPP(0xB1, 0xF);
    WS_DPP(0x4E, 0xF);
    WS_DPP(0x141, 0xF);
    WS_DPP(0x140, 0xF);
    WS_DPP(0x142, 0xA);
    WS_DPP(0x143, 0xC);
#undef WS_DPP
    return __int_as_float(__builtin_amdgcn_readlane(__float_as_int(v), 63));
}
__device__ __forceinline__ int conv_drow(int mode, int row_off, int n0) {
    if (mode == 0) return row_off + n0;
    if (mode == 1) return 256 * (n0 >> 7) + (n0 & 127);
    if (mode == 2) return 256 * (n0 >> 7) + 128 + (n0 & 127);
    const int cl = n0 & 255; return row_off + (n0 & ~255) + 128 * ((cl & 63) >> 5) + 32 * (cl >> 6);
}
struct ConvPend { f32x4 wv[8]; bf16* WT; int K, drow0, k0, valid; };
__device__ __forceinline__ void conv_finish(ConvPend& P, LAS float* scr, int lane) {
    LAS float* sp = scr + (lane >> 3) * 33 + 4 * (lane & 7);
#pragma unroll
    for (int i = 0; i < 8; ++i) { sp[(8 * i) * 33 + 0] = P.wv[i].x; sp[(8 * i) * 33 + 1] = P.wv[i].y; sp[(8 * i) * 33 + 2] = P.wv[i].z; sp[(8 * i) * 33 + 3] = P.wv[i].w; }
    LDS_WAIT(); asm volatile("" ::: "memory");
    const int c = lane & 7;
#pragma unroll
    for (int j = 0; j < 4; ++j) { const int n = (lane >> 3) + 8 * j; const LAS float* s = scr + (8 * c) * 33 + n;
        v4u o; o.x = pk2(s[0 * 33], s[1 * 33]); o.y = pk2(s[2 * 33], s[3 * 33]); o.z = pk2(s[4 * 33], s[5 * 33]); o.w = pk2(s[6 * 33], s[7 * 33]);
        *(GAS v4u*)(P.WT + (size_t)(P.drow0 + n) * P.K + P.k0 + 8 * c) = o; }
    LDS_WAIT(); asm volatile("" ::: "memory");
}
__device__ __forceinline__ int conv_matrix(Frame& F, const float* W, int K, int N, bf16* WT, int mode, int row_off, int prefix, ConvPend& P) {
    LAS float* scr = (LAS float*)(F.lds + RING_OFF + F.wave * 16384);
    const int NGW = F.G * NWAVES, gw = F.vcu * NWAVES + F.wave, nitems = (K / 64) * (N / 32), nblk = N / 32;
    int start = (gw - prefix % NGW + NGW) % NGW;
    for (int it = start; it < nitems; it += NGW) {
        const int kb = it / nblk, nb = it % nblk, k0 = 64 * kb, n0 = 32 * nb;
        f32x4 nw[8]; const float* wp = W + (size_t)(k0 + (F.lane >> 3)) * N + n0 + 4 * (F.lane & 7);
#pragma unroll
        for (int i = 0; i < 8; ++i) nw[i] = __builtin_nontemporal_load((const GAS f32x4*)(wp + (size_t)(8 * i) * N));
        if (P.valid) conv_finish(P, scr, F.lane);
#pragma unroll
        for (int i = 0; i < 8; ++i) P.wv[i] = nw[i];
        P.WT = WT; P.K = K; P.drow0 = conv_drow(mode, row_off, n0); P.k0 = k0; P.valid = 1;
    }
    return prefix + nitems;
}
__device__ __forceinline__ void rmsnorm_phase(Frame& F, const float* x, const float* g, bf16* xn) {
    const int NGW = F.G * NWAVES, gw = F.vcu * NWAVES + F.wave;
    f32x4 gv[8];
#pragma unroll
    for (int j = 0; j < 8; ++j) gv[j] = ((const GAS f32x4*)g)[64 * j + F.lane];
    f32x4 vn[8];
    if (gw < T) { const GAS f32x4* xr0 = (const GAS f32x4*)(x + (size_t)gw * D) + F.lane;
#pragma unroll
        for (int j = 0; j < 8; ++j) vn[j] = xr0[64 * j]; }
    for (int m = gw; m < T; m += NGW) {
        f32x4 v[8]; float s = 0.f;
#pragma unroll
        for (int j = 0; j < 8; ++j) { v[j] = vn[j]; s += (v[j].x * v[j].x + v[j].y * v[j].y) + (v[j].z * v[j].z + v[j].w * v[j].w); }
        if (m + NGW < T) { const GAS f32x4* xr1 = (const GAS f32x4*)(x + (size_t)(m + NGW) * D) + F.lane;
#pragma unroll
            for (int j = 0; j < 8; ++j) vn[j] = xr1[64 * j]; }
        const float rs = 1.0f / sqrtf(wave_sum(s) * (1.0f / D) + NORM_EPS);
        GAS unsigned long long* o8 = (GAS unsigned long long*)(xn + (size_t)m * D) + F.lane;
#pragma unroll
        for (int j = 0; j < 8; ++j) { const f32x4 y = v[j] * rs * gv[j]; o8[64 * j] = (unsigned long long)pk2(y.x, y.y) | ((unsigned long long)pk2(y.z, y.w) << 32); }
    }
}
__device__ __forceinline__ void sincos_d(double a, float& sn, float& cs) {
    const double k = __builtin_rint(a * 0.63661977236758134308);
    double r = __builtin_fma(-k, 1.57079632679489655800e+00, a); r = __builtin_fma(-k, 6.12323399573676603587e-17, r);
    const double r2 = r * r;
    double sp = -1.6059043836821613e-10; sp = sp * r2 + 2.5052108385441720e-08; sp = sp * r2 - 2.7557319223985893e-06; sp = sp * r2 + 1.9841269841269841e-04;
    sp = sp * r2 - 8.3333333333333332e-03; sp = sp * r2 + 1.6666666666666666e-01; const double s = r - r * r2 * sp;
    double cp = 2.0876756987868099e-09; cp = cp * r2 - 2.7557319223985888e-07; cp = cp * r2 + 2.4801587301587302e-05; cp = cp * r2 - 1.3888888888888889e-03;
    cp = cp * r2 + 4.1666666666666664e-02; const double c = 1.0 - 0.5 * r2 + r2 * r2 * cp;
    const int q = (int)((long long)k & 3);
    const double so = (q == 0) ? s : (q == 1) ? c : (q == 2) ? -s : -c, co = (q == 0) ? c : (q == 1) ? -s : (q == 2) ? -c : s;
    sn = (float)so; cs = (float)co;
}
__device__ __forceinline__ double rope_freq(int i) {
    return i == 0 ? 1.0 : i == 1 ? 0.19392274474868576 : i == 2 ? 0.037606030930863933 : i == 3 ? 0.0072926647372171093 : i == 4 ? 0.001414213562373095 :
           i == 5 ? 0.0002742481756762073 : i == 6 ? 5.3182958969449883e-05 : 1.031338537721246e-05;
}
__device__ __forceinline__ void tables_phase(Frame& F, const float* lq1, const float* lk1, const float* lq2, const float* lk2, const float* qg, const float* kg) {
    const int NT = F.G * NWAVES * 64, gt = (F.vcu * NWAVES + F.wave) * 64 + F.lane;
    float* rope = (float*)(F.ws + WS_ROPE); float* rtab = (float*)(F.ws + WS_RTAB);
    for (int e = gt; e < T * 8; e += NT) { const int pos = e >> 3, i = e & 7; float sn, cs; sincos_d((double)pos * rope_freq(i), sn, cs); *(GAS f32x2*)(rope + (size_t)e * 2) = (f32x2){cs, sn}; }
    for (int e = gt; e < T * 128; e += NT) { const int pos = e >> 7, j = e & 127;
        const double ang = exp2(-(double)j * (13.287712379549449 / 127.0));
        float sn, cs; sincos_d((double)pos * ang, sn, cs); *(GAS f32x2*)(rtab + (size_t)e * 2) = (f32x2){cs, sn}; }
    if (blockIdx.x == 0 && F.wave < 2) {
        const int l = F.wave; const float q1 = lq1[l * 64 + F.lane], k1 = lk1[l * 64 + F.lane], q2 = lq2[l * 64 + F.lane], k2 = lk2[l * 64 + F.lane];
        const float d1 = wave_sum(q1 * k1), d2 = wave_sum(q2 * k2); const float linit = (l == 0) ? 0.2f : 0.4707130183435842f;
        if (F.lane == 0) ((float*)(F.ws + WS_SMALL))[l] = expf(d1) - expf(d2) + linit;
    }
    if (blockIdx.x == 0 && F.wave >= 2 && F.wave < 4) {
        const int l = F.wave - 2; float a = fabsf(qg[l * 64 + F.lane]), b = fabsf(kg[l * 64 + F.lane]);
#pragma unroll
        for (int o = 1; o < 64; o <<= 1) { a = fmaxf(a, __shfl_xor(a, o)); b = fmaxf(b, __shfl_xor(b, o)); }
        if (F.lane == 0) ((float*)(F.ws + WS_SMALL))[2 + l] = 8.0f * a * b * 1.4426950408889634f * 1.01f;
    }
}
__device__ __forceinline__ void combine_phase(Frame& F, const bf16* O0, const bf16* O1, const float* subg, float lam, float post, bf16* ON) {
    const int NGW = F.G * NWAVES, gw = F.vcu * NWAVES + F.wave;
    f32x4 g0[4], g1[4];
#pragma unroll
    for (int i = 0; i < 4; ++i) { g0[i] = *(const GAS f32x4*)(subg + (F.lane & 15) * 8) * post; g1[i] = *(const GAS f32x4*)(subg + (F.lane & 15) * 8 + 4) * post; }
    for (int m = gw; m < T; m += NGW) {
        const GAS v4u* p0 = (const GAS v4u*)(O0 + (size_t)m * D) + F.lane; const GAS v4u* p1 = (const GAS v4u*)(O1 + (size_t)m * D) + F.lane;
        GAS v4u* po = (GAS v4u*)(ON + (size_t)m * D) + F.lane;
#pragma unroll
        for (int i = 0; i < 4; ++i) {
            const v4u a = p0[64 * i], b = p1[64 * i]; float o[8]; float ss = 0.f;
#pragma unroll
            for (int e = 0; e < 4; ++e) { const unsigned ua = a[e], ub = b[e];
                o[2 * e] = __uint_as_float(ua << 16) - lam * __uint_as_float(ub << 16); o[2 * e + 1] = __uint_as_float(ua & 0xffff0000u) - lam * __uint_as_float(ub & 0xffff0000u);
                ss += o[2 * e] * o[2 * e] + o[2 * e + 1] * o[2 * e + 1]; }
            ss += __shfl_xor(ss, 1); ss += __shfl_xor(ss, 2); ss += __shfl_xor(ss, 4); ss += __shfl_xor(ss, 8);
            const float rs = 1.0f / sqrtf(ss * (1.0f / 128.0f) + NORM_EPS);
            v4u w; w.x = pk2(o[0] * rs * g0[i][0], o[1] * rs * g0[i][1]); w.y = pk2(o[2] * rs * g0[i][2], o[3] * rs * g0[i][3]);
            w.z = pk2(o[4] * rs * g1[i][0], o[5] * rs * g1[i][1]); w.w = pk2(o[6] * rs * g1[i][2], o[7] * rs * g1[i][3]);
            po[64 * i] = w;
        }
    }
}
__device__ __forceinline__ float ret_log2gamma(int h) { return pg8::EpiRetProj::log2gamma(h); }
__device__ __forceinline__ void ret_scan_phase(Frame& F, const bf16* KZT, const bf16* VT, bf16* RT) {
    const int g = F.lane >> 4, fr = F.lane & 15, w = F.wave;
    LAS unsigned char* const ring = F.lds + RING_OFF;
    for (int s = F.vcu; s < 256; s += F.G) {
        const int h = s >> 5, dvb = (s >> 2) & 7, dkb = s & 3, dv0 = 64 * dvb + 16 * (w >> 1), dk0 = 64 * dkb + 32 * (w & 1);
        const float dec = __builtin_amdgcn_exp2f(128.0f * ret_log2gamma(h));
        const bf16* src = ((w < 4) ? KZT + (size_t)(((256 * h + 64 * dkb) >> 4) + w) * (512 * 512) : VT + (size_t)(((512 * h + 64 * dvb) >> 4) + (w - 4)) * (512 * 512)) + F.lane * 8;
        bf16* rt = RT + (((size_t)h * 32 + (dv0 >> 4)) * 8 + (dk0 >> 5)) * 512 + (fr + 16 * (g >> 1)) * 8 + 4 * (g & 1);
        f32x4 acc[2] = {(f32x4){0.f, 0.f, 0.f, 0.f}, (f32x4){0.f, 0.f, 0.f, 0.f}};
#define RS_DMA(c) do { _Pragma("unroll") for (int ks = 0; ks < 4; ++ks) __builtin_amdgcn_global_load_lds((const unsigned*)(src + (size_t)(4 * (c) + ks) * 512), (LAS unsigned*)(ring + ((c) & 3) * 32768 + (4 * w + ks) * 1024), 16, 0, 0); } while (0)
        RS_DMA(0); RS_DMA(1); RS_DMA(2);
        const LAS unsigned char* afr = ring + (4 * (2 * (w & 1))) * 1024 + F.lane * 16;
        const LAS unsigned char* bfr = ring + (16 + 4 * (w >> 1)) * 1024 + F.lane * 16;
        for (int c = 0; c < 128; ++c) {
            if (c < 3) asm volatile("s_waitcnt vmcnt(8) lgkmcnt(0)\n\ts_barrier" ::: "memory"); else if (c < 126) asm volatile("s_waitcnt vmcnt(12) lgkmcnt(0)\n\ts_barrier" ::: "memory"); else asm volatile("s_waitcnt vmcnt(0) lgkmcnt(0)\n\ts_barrier" ::: "memory");
            if (c + 3 < 128) RS_DMA(c + 3);
            asm volatile("" ::: "memory");
            bf16* rc = rt + (size_t)c * (8 * 512 * 256);
#pragma unroll
            for (int t = 0; t < 2; ++t) { pg8::u32x2 wv; wv.x = pk2(acc[t][0], acc[t][1]); wv.y = pk2(acc[t][2], acc[t][3]); *(GAS pg8::u32x2*)(rc + 256 * t) = wv; }
            if (c == 127) break;
            const int so = (c & 3) * 32768;
            bf16x8 b[4];
#pragma unroll
            for (int ks = 0; ks < 4; ++ks) b[ks] = *(const LAS bf16x8*)(bfr + so + ks * 1024);
#pragma unroll
            for (int t = 0; t < 2; ++t) { acc[t] = acc[t] * dec;
#pragma unroll
                for (int ks = 0; ks < 4; ++ks) acc[t] = __builtin_amdgcn_mfma_f32_16x16x32_bf16(*(const LAS bf16x8*)(afr + so + t * 4096 + ks * 1024), b[ks], acc[t], 0, 0, 0); }
        }
        asm volatile("s_waitcnt vmcnt(0)" ::: "memory"); __syncthreads();
#undef RS_DMA
    }
}
__device__ __forceinline__ void ret_chunk_phase(Frame& F, const bf16* QR, const bf16* KR, const bf16* VT, const bf16* GS, const bf16* RT, bf16* YN) {
    const int g = F.lane >> 4, fr = F.lane & 15, w = F.wave;
    LAS unsigned char* const bufs = F.lds + RING_OFF;
    for (int unit = F.vcu; unit < 1024; unit += F.G) {
        const int h = unit & 7, c = 127 - (unit >> 3);
        const float l2g = ret_log2gamma(h);
        const int nrow = 16 * w + fr;
        const size_t row = (size_t)128 * c + nrow;
        const char* RTu = (const char*)(RT + ((size_t)c * 8 + h) * 512 * 256) + F.lane * 16;
        const char* VTu = (const char*)(VT + ((size_t)(32 * h) * 512 + 4 * c) * 512) + F.lane * 16;
        const char* RTw = RTu + (size_t)(w >> 1) * 8192;
        const char* VTw = VTu + (size_t)(w >> 1) * (512 * 1024);
        LAS unsigned char* const dstw = bufs + ((w >> 1) * 12 + 6 * (w & 1)) * 1024;
#define R2_DMA(st, bi) do { if (w & 1) { _Pragma("unroll") for (int j = 0; j < 6; ++j) { \
                const char* src_ = (j < 2) ? RTw + (size_t)(st) * 32768 + (6 + j) * 1024 : VTw + (size_t)(st) * ((size_t)4 * 512 * 1024) + (j - 2) * 1024; \
                __builtin_amdgcn_global_load_lds((const unsigned*)src_, (LAS unsigned*)(dstw + (bi) * 49152 + j * 1024), 16, 0, 2); } } \
            else { _Pragma("unroll") for (int j = 0; j < 6; ++j) __builtin_amdgcn_global_load_lds((const unsigned*)(RTw + (size_t)(st) * 32768 + j * 1024), (LAS unsigned*)(dstw + (bi) * 49152 + j * 1024), 16, 0, 2); } } while (0)
#define R2_SYNC() do { asm volatile("s_waitcnt vmcnt(0)" ::: "memory"); __syncthreads(); } while (0)
        LAS unsigned char* const karea = bufs + 49152;
        { const bf16* ksrc = KR + ((((size_t)(8 * c + w)) * 8 + h) * 8) * 512 + F.lane * 8;
#pragma unroll
            for (int ks = 0; ks < 8; ++ks) __builtin_amdgcn_global_load_lds((const unsigned*)(ksrc + 512 * ks), (LAS unsigned*)(karea + (w * 8 + ks) * 1024), 16, 0, 0); }
        R2_DMA(0, 0);
        bf16x8 qf[8];
#pragma unroll
        for (int ks = 0; ks < 8; ++ks) qf[ks] = *(const GAS bf16x8*)(QR + ((((size_t)(8 * c + w)) * 8 + h) * 8 + ks) * 512 + F.lane * 8);
        R2_SYNC();
        pg8::u32x2 pk[8];
#pragma unroll
        for (int mt = 0; mt < 8; ++mt) {
            if (mt <= w) {
                f32x4 s = (f32x4){0.f, 0.f, 0.f, 0.f};
#pragma unroll
                for (int ks = 0; ks < 8; ++ks) s = __builtin_amdgcn_mfma_f32_16x16x32_bf16(*(const LAS bf16x8*)(karea + (mt * 8 + ks) * 1024 + F.lane * 16), qf[ks], s, 0, 0, 0);
                float pv[4];
#pragma unroll
                for (int r = 0; r < 4; ++r) { const int d = nrow - (16 * mt + 4 * g + r); pv[r] = d >= 0 ? s[r] * __builtin_amdgcn_exp2f(l2g * (float)d) : 0.f; }
                pk[mt].x = pk2(pv[0], pv[1]); pk[mt].y = pk2(pv[2], pv[3]);
            } else { pk[mt].x = 0u; pk[mt].y = 0u; }
        }
        const float xi = __builtin_amdgcn_exp2f(l2g * (float)(nrow + 1));
        R2_SYNC();
        f32x4 Y[32];
#pragma unroll
        for (int st = 0; st < 8; ++st) {
            if (st + 1 < 8) R2_DMA(st + 1, (st + 1) & 1);
            const LAS unsigned char* bb = bufs + (st & 1) * 49152 + F.lane * 16;
#pragma unroll
            for (int dl = 0; dl < 4; ++dl) {
                f32x4 y = (f32x4){0.f, 0.f, 0.f, 0.f};
#pragma unroll
                for (int ks = 0; ks < 8; ++ks) y = __builtin_amdgcn_mfma_f32_16x16x32_bf16(*(const LAS bf16x8*)(bb + (dl * 12 + ks) * 1024), qf[ks], y, 0, 0, 0);
                y = y * xi;
#pragma unroll
                for (int k2 = 0; k2 < 4; ++k2) {
                    if (2 * k2 <= w) { const v4u bv = {pk[2 * k2].x, pk[2 * k2].y, pk[2 * k2 + 1].x, pk[2 * k2 + 1].y};
                        y = __builtin_amdgcn_mfma_f32_16x16x32_bf16(*(const LAS bf16x8*)(bb + (dl * 12 + 8 + k2) * 1024), __builtin_bit_cast(bf16x8, bv), y, 0, 0, 0); }
                }
                Y[4 * st + dl] = y;
            }
            R2_SYNC();
        }
#undef R2_DMA
#undef R2_SYNC
        float sum = 0.f;
#pragma unroll
        for (int dvt = 0; dvt < 32; ++dvt) sum += (Y[dvt][0] + Y[dvt][1]) + (Y[dvt][2] + Y[dvt][3]);
        sum += __shfl_xor(sum, 16); sum += __shfl_xor(sum, 32);
        const float mean = sum * (1.0f / 512.0f); float var = 0.f;
#pragma unroll
        for (int dvt = 0; dvt < 32; ++dvt) { const f32x4 dlt = Y[dvt] - mean; var += (dlt[0] * dlt[0] + dlt[1] * dlt[1]) + (dlt[2] * dlt[2] + dlt[3] * dlt[3]); }
        var += __shfl_xor(var, 16); var += __shfl_xor(var, 32);
        const float rstd = 1.0f / sqrtf(var * (1.0f / 512.0f) + NORM_EPS);
        const bf16* gp = GS + row * 4096 + 512 * h + 4 * g; bf16* op = YN + row * 4096 + 512 * h + 4 * g;
#pragma unroll
        for (int hb = 0; hb < 2; ++hb) {
            pg8::u32x2 gvv[16];
#pragma unroll
            for (int d = 0; d < 16; ++d) gvv[d] = *(const GAS pg8::u32x2*)(gp + 16 * (16 * hb + d));
#pragma unroll
            for (int d = 0; d < 16; ++d) { const int dvt = 16 * hb + d; const pg8::u32x2 gv = gvv[d];
                const float g0 = __uint_as_float(gv.x << 16), g1 = __uint_as_float(gv.x & 0xffff0000u), g2 = __uint_as_float(gv.y << 16), g3 = __uint_as_float(gv.y & 0xffff0000u);
                const f32x4 yh = (Y[dvt] - mean) * rstd;
                pg8::u32x2 o; o.x = pk2(yh[0] * g0, yh[1] * g1); o.y = pk2(yh[2] * g2, yh[3] * g3);
                *(GAS pg8::u32x2*)(op + 16 * dvt) = o; }
        }
    }
}

struct Args { const float* in[26]; float* out; unsigned char* ws; int ph_lo, ph_hi; };
#define INP(k) (args.in[k])
#define XOUT (args.out)
#define PH_ON (lo <= ph && ph < hi)
#define PH_END do { if (lo <= ph && ph + 1 < hi) { xcd_barrier(bar); if (REP(13) > 1) { xcd_barrier(bar); xcd_barrier(bar); xcd_barrier(bar); } } ++ph; } while (0)
#define FFN_GEMMS(WGU, WD, XIN) do { \
        if (PH_ON && EN(2)) { pg8::Gemm gg{((bf16*)(F.ws + WS_XN)), (const bf16*)(F.ws + (WGU)), M, 2 * FF, D}; pg8::StaticOrder S; S.init(M, 2 * FF, F.G, (int)blockIdx.x); \
            pg8::EpiSwiGLU E{(bf16*)(F.ws + WS_H), FF}; pg8::gemm_phase<pg8::EpiSwiGLU, pg8::StaticOrder, PG8_ALIGN, PG8_SP2>(F.lds + RING_OFF, gg, S, E); \
            if (REP(2) > 1) pg8::gemm_phase<pg8::EpiSwiGLU, pg8::StaticOrder, PG8_ALIGN, PG8_SP2>(F.lds + RING_OFF, gg, S, E); } \
        PH_END; \
        if (PH_ON && EN(3)) { pg8::Gemm gg{(const bf16*)(F.ws + WS_H), (const bf16*)(F.ws + (WD)), M, D, FF}; pg8::StaticOrder S; S.init(M, D, F.G, (int)blockIdx.x); \
            pg8::EpiResid E{(XIN), XOUT, D, 0.5f}; \
            if (REP(3) > 1) { pg8::EpiResid E2{(XIN), (float*)(F.ws + WS_END + 4 * MiB), D, 0.5f}; pg8::gemm_phase<pg8::EpiResid, pg8::StaticOrder, PG8_ALIGN, PG8_SP2>(F.lds + RING_OFF, gg, S, E2); } \
            pg8::gemm_phase<pg8::EpiResid, pg8::StaticOrder, PG8_ALIGN, PG8_SP2>(F.lds + RING_OFF, gg, S, E); } \
        PH_END; } while (0)
#define CONV_FFN(i) do { \
        pfx = conv_matrix(F, INP(2) + (size_t)(i) * D * FF, D, FF, (bf16*)(F.ws + WS_W1GU), 1, 0, pfx, CP); pfx = conv_matrix(F, INP(3) + (size_t)(i) * D * FF, D, FF, (bf16*)(F.ws + WS_W1GU), 2, 0, pfx, CP); \
        pfx = conv_matrix(F, INP(4) + (size_t)(i) * FF * D, FF, D, (bf16*)(F.ws + WS_W1D), 0, 0, pfx, CP); \
        pfx = conv_matrix(F, INP(23) + (size_t)(i) * D * FF, D, FF, (bf16*)(F.ws + WS_W2GU), 1, 0, pfx, CP); pfx = conv_matrix(F, INP(24) + (size_t)(i) * D * FF, D, FF, (bf16*)(F.ws + WS_W2GU), 2, 0, pfx, CP); \
        pfx = conv_matrix(F, INP(25) + (size_t)(i) * FF * D, FF, D, (bf16*)(F.ws + WS_W2D), 0, 0, pfx, CP); } while (0)

template <int lp> __device__ __forceinline__ void layer_pair(const Args& args, Frame& F, unsigned char* lds, const XcdBarrier& bar, const int lo, const int hi, int& ph) {
        {
            const int li = 2 * lp;
            const float* xin = (lp == 0) ? INP(0) : XOUT;
            if (PH_ON) {
                if (EN(0)) { if (lp == 0) { tables_phase(F, INP(12), INP(13), INP(14), INP(15), INP(10), INP(11)); if (REP(12) > 1) tables_phase(F, INP(12), INP(13), INP(14), INP(15), INP(10), INP(11)); }
                int pfx = 0; ConvPend CP; CP.valid = 0; CONV_FFN(li); if (REP(0) > 1) CONV_FFN(li);
                pfx = conv_matrix(F, INP(6) + (size_t)lp * D * D, D, 2048, (bf16*)(F.ws + WS_WMIX), 3, 0, pfx, CP); pfx = conv_matrix(F, INP(7) + (size_t)lp * D * D, D, 2048, (bf16*)(F.ws + WS_WMIX), 3, 2048, pfx, CP);
                pfx = conv_matrix(F, INP(8) + (size_t)lp * D * D, D, 2048, (bf16*)(F.ws + WS_WMIX), 3, 4096, pfx, CP); pfx = conv_matrix(F, INP(9) + (size_t)lp * D * D, 2048, D, (bf16*)(F.ws + WS_WMIX + 24 * MiB), 0, 0, pfx, CP);
                if (CP.valid) conv_finish(CP, (LAS float*)(F.lds + RING_OFF + F.wave * 16384), F.lane); }
                if (EN(1)) rmsnorm_phase(F, xin, INP(1) + (size_t)li * D, ((bf16*)(F.ws + WS_XN)));
            }
            PH_END;
            FFN_GEMMS(WS_W1GU, WS_W1D, xin);
            if (PH_ON && EN(1)) { if (REP(1) > 1) rmsnorm_phase(F, XOUT, INP(5) + (size_t)li * D, ((bf16*)(F.ws + WS_XN))); rmsnorm_phase(F, XOUT, INP(5) + (size_t)li * D, ((bf16*)(F.ws + WS_XN))); }
            PH_END;
            if (PH_ON && EN(4)) {
                pg8::Gemm gg{((bf16*)(F.ws + WS_XN)), (const bf16*)(F.ws + WS_WMIX), M, 6144, D}; pg8::StaticOrder S; S.init(M, 6144, F.G, (int)blockIdx.x);
                pg8::EpiQKVDiff E{(bf16*)(F.ws + WS_Q), (bf16*)(F.ws + WS_K), (bf16*)(F.ws + WS_V), INP(10) + lp * 64, INP(11) + lp * 64, (const float*)(F.ws + WS_ROPE), attn_body::C2, M};
                pg8::gemm_phase<pg8::EpiQKVDiff, pg8::StaticOrder, PG8_ALIGN, PG8_SP2>(F.lds + RING_OFF, gg, S, E);
                if (REP(4) > 1) pg8::gemm_phase<pg8::EpiQKVDiff, pg8::StaticOrder, PG8_ALIGN, PG8_SP2>(F.lds + RING_OFF, gg, S, E);
            }
            PH_END;
            if (PH_ON && EN(5)) {
                static_assert(da::LDS_END <= RING_BYTES && da::PITCH == D, "attention body geometry vs frame");
                const float linit = (lp == 0) ? 0.2f : 0.4707130183435842f;
                const da::Tensors AT{(const attn_body::bf16*)(F.ws + WS_Q), (const attn_body::bf16*)(F.ws + WS_K), (const attn_body::bf16*)(F.ws + WS_V), (attn_body::bf16*)(F.ws + WS_ON),
                                     INP(16) + lp * 128, __int_as_float(__builtin_amdgcn_readfirstlane(__float_as_int(((const float*)(F.ws + WS_SMALL))[lp]))), 1.0f - linit,
                                     __int_as_float(__builtin_amdgcn_readfirstlane(__float_as_int(((const float*)(F.ws + WS_SMALL))[2 + lp])))};
                da::phase((char*)lds + RING_OFF, AT, F.vcu);
                if (REP(5) > 1) da::phase((char*)lds + RING_OFF, AT, F.vcu);
            }
            PH_END;
            if (PH_ON && EN(7)) { pg8::Gemm gg{(const bf16*)(F.ws + WS_ON), (const bf16*)(F.ws + WS_WMIX + 24 * MiB), M, D, 2048}; pg8::StaticOrder S; S.init(M, D, F.G, (int)blockIdx.x);
                pg8::EpiResid E{XOUT, XOUT, D, 1.0f};
                if (REP(7) > 1) { pg8::EpiResid E2{XOUT, (float*)(F.ws + WS_END + 4 * MiB), D, 1.0f}; pg8::gemm_phase<pg8::EpiResid, pg8::StaticOrder, PG8_ALIGN, PG8_SP2>(F.lds + RING_OFF, gg, S, E2); }
                pg8::gemm_phase<pg8::EpiResid, pg8::StaticOrder, PG8_ALIGN, PG8_SP2>(F.lds + RING_OFF, gg, S, E); }
            PH_END;
            if (PH_ON && EN(1)) { if (REP(1) > 1) rmsnorm_phase(F, XOUT, INP(22) + (size_t)li * D, ((bf16*)(F.ws + WS_XN))); rmsnorm_phase(F, XOUT, INP(22) + (size_t)li * D, ((bf16*)(F.ws + WS_XN))); }
            PH_END;
            FFN_GEMMS(WS_W2GU, WS_W2D, XOUT);
        }
        {
            const int li = 2 * lp + 1;
            if (PH_ON) {
                if (EN(0)) { int pfx = 0; ConvPend CP; CP.valid = 0; CONV_FFN(li); if (REP(0) > 1) CONV_FFN(li);
                bf16* WP = (bf16*)(F.ws + WS_WMIX);
                pfx = conv_matrix(F, INP(17) + (size_t)lp * D * 2048, D, 2048, WP, 0, 0, pfx, CP); pfx = conv_matrix(F, INP(18) + (size_t)lp * D * 2048, D, 2048, WP, 0, 2048, pfx, CP);
                pfx = conv_matrix(F, INP(19) + (size_t)lp * D * 4096, D, 4096, WP, 0, 4096, pfx, CP); pfx = conv_matrix(F, INP(20) + (size_t)lp * D * 4096, D, 4096, WP, 0, 8192, pfx, CP);
                pfx = conv_matrix(F, INP(21) + (size_t)lp * 4096 * D, 4096, D, (bf16*)(F.ws + WS_WMIX + 48 * MiB), 0, 0, pfx, CP);
                if (CP.valid) conv_finish(CP, (LAS float*)(F.lds + RING_OFF + F.wave * 16384), F.lane); }
                if (EN(1)) rmsnorm_phase(F, XOUT, INP(1) + (size_t)li * D, ((bf16*)(F.ws + WS_XN)));
            }
            PH_END;
            FFN_GEMMS(WS_W1GU, WS_W1D, XOUT);
            if (PH_ON && EN(1)) { if (REP(1) > 1) rmsnorm_phase(F, XOUT, INP(5) + (size_t)li * D, ((bf16*)(F.ws + WS_XN))); rmsnorm_phase(F, XOUT, INP(5) + (size_t)li * D, ((bf16*)(F.ws + WS_XN))); }
            PH_END;
            if (PH_ON && EN(8)) {
                pg8::Gemm gg{((bf16*)(F.ws + WS_XN)), (const bf16*)(F.ws + WS_WMIX), M, 12288, D}; pg8::StaticOrder S; S.init(M, 12288, F.G, (int)blockIdx.x);
                pg8::EpiRetProj E{(bf16*)(F.ws + WS_QR), (bf16*)(F.ws + WS_KR), (bf16*)(F.ws + WS_KZT), (bf16*)(F.ws + WS_VT), (bf16*)(F.ws + WS_GS), (const float*)(F.ws + WS_RTAB)};
                pg8::gemm_phase<pg8::EpiRetProj, pg8::StaticOrder, PG8_ALIGN, PG8_SP2>(F.lds + RING_OFF, gg, S, E);
                if (REP(8) > 1) pg8::gemm_phase<pg8::EpiRetProj, pg8::StaticOrder, PG8_ALIGN, PG8_SP2>(F.lds + RING_OFF, gg, S, E);
            }
            PH_END;
            if (PH_ON && EN(9)) for (int rp_ = 0; rp_ < REP(9); ++rp_) ret_scan_phase(F, (const bf16*)(F.ws + WS_KZT), (const bf16*)(F.ws + WS_VT), (bf16*)(F.ws + WS_RT));
            PH_END;
            if (PH_ON && EN(10)) { if (REP(10) > 1) ret_chunk_phase(F, (const bf16*)(F.ws + WS_QR), (const bf16*)(F.ws + WS_KR), (const bf16*)(F.ws + WS_VT), (const bf16*)(F.ws + WS_GS), (const bf16*)(F.ws + WS_RT), (bf16*)(F.ws + WS_END + 4 * MiB));
                ret_chunk_phase(F, (const bf16*)(F.ws + WS_QR), (const bf16*)(F.ws + WS_KR), (const bf16*)(F.ws + WS_VT), (const bf16*)(F.ws + WS_GS), (const bf16*)(F.ws + WS_RT), (bf16*)(F.ws + WS_GS)); }
            PH_END;
            if (PH_ON && EN(11)) { pg8::Gemm gg{(const bf16*)(F.ws + WS_GS), (const bf16*)(F.ws + WS_WMIX + 48 * MiB), M, D, 4096}; pg8::StaticOrder S; S.init(M, D, F.G, (int)blockIdx.x);
                pg8::EpiResid E{XOUT, XOUT, D, 1.0f};
                if (REP(7) > 1) { pg8::EpiResid E2{XOUT, (float*)(F.ws + WS_END + 4 * MiB), D, 1.0f}; pg8::gemm_phase<pg8::EpiResid, pg8::StaticOrder, PG8_ALIGN, PG8_SP2>(F.lds + RING_OFF, gg, S, E2); }
                pg8::gemm_phase<pg8::EpiResid, pg8::StaticOrder, PG8_ALIGN, PG8_SP2>(F.lds + RING_OFF, gg, S, E); }
            PH_END;
            if (PH_ON && EN(1)) { if (REP(1) > 1) rmsnorm_phase(F, XOUT, INP(22) + (size_t)li * D, ((bf16*)(F.ws + WS_XN))); rmsnorm_phase(F, XOUT, INP(22) + (size_t)li * D, ((bf16*)(F.ws + WS_XN))); }
            PH_END;
            FFN_GEMMS(WS_W2GU, WS_W2D, XOUT);
        }
    }
#undef PH_ON
#undef PH_END
#undef FFN_GEMMS
#undef CONV_FFN
__global__ void __launch_bounds__(NWAVES * 64, 2) fwd_kernel(Args args) {
    extern __shared__ __attribute__((aligned(16))) unsigned char lds[];
    Frame F;
    F.lds = (LAS unsigned char*)lds;
    F.MISC = (volatile LAS unsigned*)(F.lds + MISC_OFF);
    F.tid = threadIdx.x; F.lane = F.tid & 63; F.wave = __builtin_amdgcn_readfirstlane(F.tid >> 6);
    F.G = gridDim.x; { const int bx = blockIdx.x; F.vcu = (F.G % 8 == 0) ? (bx % 8) * (F.G / 8) + bx / 8 : bx; }
    F.ws = args.ws; F.ctl = (gu32*)(args.ws + WS_CTL);
    for (int u = F.tid; u < (LDS_BYTES - LDSCTL_OFF) / 4; u += NWAVES * 64) ((LAS unsigned*)(F.lds + LDSCTL_OFF))[u] = 0u;
    __syncthreads();
    const int lo = args.ph_lo, hi = args.ph_hi;
    XcdBarrier bar; bar.bar = (unsigned*)(F.ctl + CW_BAR); bar.x = 0; bar.st = nullptr;
    if (hi - lo > 1) bar = xcd_barrier_post((unsigned*)(F.ctl + CW_BAR), F.MISC + 8);
    int ph = 0;
    layer_pair<0>(args, F, lds, bar, lo, hi, ph);
    layer_pair<1>(args, F, lds, bar, lo, hi, ph);
}

extern "C" void kernel_launch(void* const* d_in, const int* in_sizes, int n_in, void* d_out, int out_size, void* d_ws, size_t ws_size, hipStream_t stream) {
    static int grid = 0;
    if (grid == 0) {
        if (n_in != 26 || in_sizes[0] != M * D || out_size != M * D || ws_size < WS_END) { fprintf(stderr, "kernel_launch: unexpected shapes / workspace (n_in %d, ws %zu)\n", n_in, ws_size); grid = -1; return; }
        int dev = 0, cus = 0, per_cu = 0;
        if (hipGetDevice(&dev) != hipSuccess || hipDeviceGetAttribute(&cus, hipDeviceAttributeMultiprocessorCount, dev) != hipSuccess) { grid = -1; return; }
        if (hipFuncSetAttribute((const void*)fwd_kernel, hipFuncAttributeMaxDynamicSharedMemorySize, LDS_BYTES) != hipSuccess) { fprintf(stderr, "kernel_launch: hipFuncSetAttribute failed\n"); grid = -1; return; }
        if (hipOccupancyMaxActiveBlocksPerMultiprocessor(&per_cu, (const void*)fwd_kernel, NWAVES * 64, LDS_BYTES) != hipSuccess || per_cu < 1) { fprintf(stderr, "kernel_launch: occupancy query reports %d\n", per_cu); }
        (void)hipGetLastError();
        grid = cus;
        if (grid != 256) { fprintf(stderr, "kernel_launch: built for 256 CUs, found %d\n", cus); grid = -1; return; }
    }
    if (grid < 0) return;
    if (hipMemsetAsync((char*)d_ws + WS_CTL, 0, CTL_ZERO_BYTES, stream) != hipSuccess) return;
    Args a{};
    for (int i = 0; i < 26; ++i) a.in[i] = (const float*)d_in[i];
    a.out = (float*)d_out; a.ws = (unsigned char*)d_ws;
#if MK_SPLIT
    for (int p = 0; p < N_PHASES; ++p) { a.ph_lo = p; a.ph_hi = p + 1; hipLaunchKernelGGL(fwd_kernel, dim3(grid), dim3(NWAVES * 64), LDS_BYTES, stream, a); }
#else
    a.ph_lo = 0; a.ph_hi = N_PHASES;
    hipLaunchKernelGGL(fwd_kernel, dim3(grid), dim3(NWAVES * 64), LDS_BYTES, stream, a);
#endif
}
```

```cpp
#include <hip/hip_runtime.h>
#include <hip/hip_bf16.h>
#include <cstdio>
#include <cstdint>
#include <cmath>
namespace pg8 {
#define PG8_LAS __attribute__((address_space(3)))
typedef unsigned short bf16_t;
typedef short bf16x8 __attribute__((ext_vector_type(8)));
typedef float f32x4 __attribute__((ext_vector_type(4)));
typedef unsigned u32x4 __attribute__((ext_vector_type(4)));
constexpr int BM = 256, BK = 64, HALF = 128, HTB = HALF * BK * 2  , STAGE_BYTES = 8 * HTB, NXCD = 8, WGM = 8;

__host__ __device__ __forceinline__ int lds_byte(int r, int c) { const int st = (r >> 4) * 2 + (c >> 5), rr = r & 15, cc = c & 31, ob = rr * 64 + cc * 2; return st * 1024 + (ob ^ (((ob >> 9) & 1) << 5)); }
__host__ __device__ __forceinline__ void stage_rc(int b, int& R, int& C) { const int st = b / 1024, sb = b % 1024, swz = sb ^ (((sb >> 9) & 1) << 5); R = (st >> 1) * 16 + swz / 64; C = (st & 1) * 32 + (swz % 64) / 2; }
__host__ __device__ __forceinline__ int perm32(int rho) { const int n = rho >> 4, i = rho & 15; return 8 * (i >> 2) + 4 * n + (i & 3); }

struct Unit { int pm, pn; };
struct Gemm { const bf16_t* A; const bf16_t* Bt; int M, N, K; };

struct StaticOrder {
    int nM, nN, nwg, G, c;
    __host__ __device__ void init(int M, int N, int G_, int c_) { nM = M / BM; nN = N / BM; nwg = nM * nN; G = G_; c = c_; }
    __host__ __device__ bool next(int i, Unit& u) const {
        const long L = (long)i * G + c; if (L >= nwg) return false;
        int wgid = (int)L; { const int q = nwg / NXCD, r = nwg % NXCD, xcd = wgid % NXCD, off = wgid / NXCD; wgid = (xcd < r ? xcd * (q + 1) : r * (q + 1) + (xcd - r) * q) + off; }
        const int nig = WGM * nN, gid = wgid / nig, fm = gid * WGM, gsz = (nM - fm) < WGM ? (nM - fm) : WGM;
        u.pm = fm + ((wgid % nig) % gsz); u.pn = (wgid % nig) / gsz; return true;
    }
    __device__ __forceinline__ void a_ready(const Unit&) const {}
    __device__ __forceinline__ void done(const Unit&) const {}
};

__device__ __forceinline__ unsigned cvt_pk_bf16(float lo, float hi) { unsigned r; asm volatile("v_cvt_pk_bf16_f32 %0, %1, %2" : "=v"(r) : "v"(lo), "v"(hi)); return r; }
typedef float f32x2 __attribute__((ext_vector_type(2)));
typedef unsigned u32x2 __attribute__((ext_vector_type(2)));
__device__ __forceinline__ float silu_f(float g) { return g * __builtin_amdgcn_rcpf(1.0f + __builtin_amdgcn_exp2f(-1.4426950408889634f * g)); }
__device__ __forceinline__ f32x2 silu2_mul(const f32x2 g, const f32x2 u) {
    const f32x2 t = g * (f32x2){-1.4426950408889634f, -1.4426950408889634f};
    const f32x2 d = (f32x2){__builtin_amdgcn_exp2f(t.x), __builtin_amdgcn_exp2f(t.y)} + (f32x2){1.0f, 1.0f};
    const f32x2 r = {__builtin_amdgcn_rcpf(d.x), __builtin_amdgcn_rcpf(d.y)};
    return (g * r) * u;
}
__device__ __forceinline__ u32x4 pack8(const f32x4 a, const f32x4 b) { u32x4 w; w.x = cvt_pk_bf16(a[0], a[1]); w.y = cvt_pk_bf16(a[2], a[3]); w.z = cvt_pk_bf16(b[0], b[1]); w.w = cvt_pk_bf16(b[2], b[3]); return w; }
__device__ __forceinline__ bf16_t f2bf1(float f) { return (bf16_t)(cvt_pk_bf16(f, 0.f) & 0xffffu); }

struct EpiSwiGLU {
    static constexpr bool PERM = true, AFTER_DRAIN = false;
    bf16_t* O; int ldc;
    __device__ __forceinline__ void operator()(const f32x4 (&acc)[2][2][4][2], const Unit& u, int wr, int wc, int fr, int fq) const {
        const int row0 = u.pm * BM + wr * 64 + fr, col0 = u.pn * HALF + wc * 32 + 8 * fq;
#pragma unroll
        for (int ai = 0; ai < 2; ++ai)
#pragma unroll
            for (int m = 0; m < 4; ++m) {
                f32x4 v0, v1;
#pragma unroll
                for (int j = 0; j < 4; j += 2) { const f32x2 a = silu2_mul((f32x2){acc[ai][0][m][0][j], acc[ai][0][m][0][j + 1]}, (f32x2){acc[ai][1][m][0][j], acc[ai][1][m][0][j + 1]});
                    const f32x2 b = silu2_mul((f32x2){acc[ai][0][m][1][j], acc[ai][0][m][1][j + 1]}, (f32x2){acc[ai][1][m][1][j], acc[ai][1][m][1][j + 1]});
                    v0[j] = a.x; v0[j + 1] = a.y; v1[j] = b.x; v1[j + 1] = b.y; }
                *(u32x4*)(O + (size_t)(row0 + ai * HALF + m * 16) * ldc + col0) = pack8(v0, v1);
            }
    }
};
struct EpiResid {
    static constexpr bool PERM = false, AFTER_DRAIN = false;
    const float* base; float* out; int ldc; float scale;
    __device__ __forceinline__ void operator()(const f32x4 (&acc)[2][2][4][2], const Unit& u, int wr, int wc, int fr, int fq) const {
        const int row0 = u.pm * BM + wr * 64 + fr, col0 = u.pn * BM + wc * 32 + 4 * fq;
#pragma unroll
        for (int ai = 0; ai < 2; ++ai) {
            f32x4 b[4][2][2];
#pragma unroll
            for (int m = 0; m < 4; ++m) { const size_t off = (size_t)(row0 + ai * HALF + m * 16) * ldc + col0;
#pragma unroll
                for (int bj = 0; bj < 2; ++bj)
#pragma unroll
                    for (int n = 0; n < 2; ++n) b[m][bj][n] = *(const f32x4*)(base + off + bj * HALF + n * 16); }
#pragma unroll
            for (int m = 0; m < 4; ++m) { const size_t off = (size_t)(row0 + ai * HALF + m * 16) * ldc + col0;
#pragma unroll
                for (int bj = 0; bj < 2; ++bj)
#pragma unroll
                    for (int n = 0; n < 2; ++n) *(f32x4*)(out + off + bj * HALF + n * 16) = b[m][bj][n] + acc[ai][bj][m][n] * scale; }
        }
    }
};
struct EpiQKVDiff {
    static constexpr bool PERM = true, AFTER_DRAIN = false;
    bf16_t *Q, *K, *V; const float* qg; const float* kg; const float* rope; float qscale; int Mrows;
    __device__ __forceinline__ void operator()(const f32x4 (&acc)[2][2][4][2], const Unit& u, int wr, int wc, int fr, int fq) const {
        const int sec = u.pn >> 3, colbase = (u.pn & 7) * 256 + wc * 64 + 8 * fq, row0 = u.pm * BM + wr * 64 + fr;
        if (sec == 2) {
#pragma unroll
            for (int ai = 0; ai < 2; ++ai)
#pragma unroll
                for (int m = 0; m < 4; ++m) { bf16_t* rp = V + ((size_t)(colbase >> 7) * Mrows + (row0 + ai * HALF + m * 16)) * 128 + (colbase & 127);
#pragma unroll
                    for (int bj = 0; bj < 2; ++bj) *(u32x4*)(rp + 32 * bj) = pack8(acc[ai][bj][m][0], acc[ai][bj][m][1]); }
        } else {
            const float* gp = sec == 0 ? qg : kg; bf16_t* dst = sec == 0 ? Q : K; const float sc = sec == 0 ? qscale : 1.0f;
            f32x4 gv[2][2];
#pragma unroll
            for (int bj = 0; bj < 2; ++bj)
#pragma unroll
                for (int n = 0; n < 2; ++n) gv[bj][n] = *(const f32x4*)(gp + 32 * bj + 8 * fq + 4 * n) * sc;
            const float sgn = (fq == 0) ? -1.0f : 1.0f; const bool rot = fq < 2;
            f32x4 tn0, tn1, tn2, tn3;
            { const f32x4* tr = (const f32x4*)(rope + (size_t)row0 * 16); tn0 = tr[0]; tn1 = tr[1]; tn2 = tr[2]; tn3 = tr[3]; }
#pragma unroll
            for (int ai = 0; ai < 2; ++ai)
#pragma unroll
                for (int m = 0; m < 4; ++m) {
                    const int row = row0 + ai * HALF + m * 16;
                    const f32x4 t0 = tn0, t1 = tn1, t2 = tn2, t3 = tn3;
                    if (ai * 4 + m + 1 < 8) { const int nrow_ = row0 + ((ai * 4 + m + 1) >> 2) * HALF + ((ai * 4 + m + 1) & 3) * 16;
                        const f32x4* tr = (const f32x4*)(rope + (size_t)nrow_ * 16); tn0 = tr[0]; tn1 = tr[1]; tn2 = tr[2]; tn3 = tr[3]; }
                    f32x4 a00 = acc[ai][0][m][0], a01 = acc[ai][0][m][1], a10 = acc[ai][1][m][0], a11 = acc[ai][1][m][1];
                    float ss = 0.f;
#pragma unroll
                    for (int j = 0; j < 4; ++j) ss += a00[j] * a00[j] + a01[j] * a01[j] + a10[j] * a10[j] + a11[j] * a11[j];
                    ss += __shfl_xor(ss, 16); ss += __shfl_xor(ss, 32);
                    const float rs = __builtin_amdgcn_rsqf(ss * (1.0f / 64.0f) + 1e-6f);
                    f32x4 y00 = a00 * rs * gv[0][0], y01 = a01 * rs * gv[0][1]; const f32x4 y10 = a10 * rs * gv[1][0], y11 = a11 * rs * gv[1][1];
                    f32x4 p0, p1;
#pragma unroll
                    for (int j = 0; j < 4; ++j) { p0[j] = __shfl_xor(y00[j], 16); p1[j] = __shfl_xor(y01[j], 16); }
                    f32x4 r0, r1;
                    r0[0] = y00[0] * t0[0] + sgn * p0[0] * t0[1]; r0[1] = y00[1] * t0[2] + sgn * p0[1] * t0[3];
                    r0[2] = y00[2] * t1[0] + sgn * p0[2] * t1[1]; r0[3] = y00[3] * t1[2] + sgn * p0[3] * t1[3];
                    r1[0] = y01[0] * t2[0] + sgn * p1[0] * t2[1]; r1[1] = y01[1] * t2[2] + sgn * p1[1] * t2[3];
                    r1[2] = y01[2] * t3[0] + sgn * p1[2] * t3[1]; r1[3] = y01[3] * t3[2] + sgn * p1[3] * t3[3];
                    if (rot) { y00 = r0; y01 = r1; }
                    bf16_t* rp = dst + ((size_t)(colbase >> 6) * Mrows + row) * 64 + (colbase & 63);
                    *(u32x4*)(rp) = pack8(y00, y01); *(u32x4*)(rp + 32) = pack8(y10, y11);
                }
        }
    }
};
__device__ __forceinline__ float dpp_x1(float x) { return __int_as_float(__builtin_amdgcn_mov_dpp(__float_as_int(x), 0xB1, 0xF, 0xF, true)); }
__device__ __forceinline__ float dpp_x2(float x) { return __int_as_float(__builtin_amdgcn_mov_dpp(__float_as_int(x), 0x4E, 0xF, 0xF, true)); }
__device__ __forceinline__ void quad_tr(float (&a)[4], bool o1, bool o2) {
    { const float r = dpp_x1(o1 ? a[0] : a[1]); if (o1) a[0] = r; else a[1] = r; }
    { const float r = dpp_x1(o1 ? a[2] : a[3]); if (o1) a[2] = r; else a[3] = r; }
    { const float r = dpp_x2(o2 ? a[0] : a[2]); if (o2) a[0] = r; else a[2] = r; }
    { const float r = dpp_x2(o2 ? a[1] : a[3]); if (o2) a[1] = r; else a[3] = r; }
}
struct EpiRetProj {
    static constexpr bool PERM = true, AFTER_DRAIN = false;
    bf16_t *QR, *KR, *KZT, *VT, *GS; const float* tab;
    __device__ __forceinline__ static float log2gamma(int h) {
        return h == 0 ? -0.045803689613124789f : h == 1 ? -0.022720076500083529f : h == 2 ? -0.011315313227834146f : h == 3 ? -0.0056465631411420627f :
               h == 4 ? -0.0028205190623786626f : h == 5 ? -0.0014095702546713536f : h == 6 ? -0.00070461297658937271f : -0.00035226347162902138f;
    }
    __device__ __forceinline__ static size_t qk_off(int tok, int h, int dim0) { return ((((size_t)(tok >> 4) * 8 + h) * 8 + (dim0 >> 5)) * 64 + (tok & 15) + 16 * ((dim0 & 31) >> 3)) * 8; }
    __device__ __forceinline__ static size_t tr_off(int r, int tok) { const int p = 8 * ((tok & 15) >> 2) + 4 * ((tok >> 4) & 1) + (tok & 3);
        return ((((size_t)(r >> 4) * 512 + (tok >> 5)) * 64) + (r & 15) + 16 * (p >> 3)) * 8 + (p & 7); }
    __device__ __forceinline__ void operator()(const f32x4 (&acc)[2][2][4][2], const Unit& u, int wr, int wc, int fr, int fq) const {
        const int pn = u.pn, row0 = u.pm * BM + wr * 64 + fr, cl = wc * 32 + 8 * fq;
        const bool o1 = fr & 1, o2 = fr & 2; const int qd = fr >> 2, rl = fr & 3;
        if (pn < 16) {
            const bool isk = pn >= 8; const int h = pn & 7; const float sc = isk ? 0.0625f : 1.0f; bf16_t* dst = isk ? KR : QR; const float l2g = log2gamma(h);
            f32x4 tq[2][2];
#define RP_TLOAD(ib_) do { const int ai_ = (ib_) >> 2, mp_ = ((ib_) >> 1) & 1, bj_ = (ib_) & 1; _Pragma("unroll") for (int mm_ = 0; mm_ < 2; ++mm_) { \
                const f32x4* tp_ = (const f32x4*)(tab + ((size_t)(row0 + ai_ * HALF + (2 * mp_ + mm_) * 16) * 128 + ((128 * bj_ + cl) >> 1)) * 2); tq[mm_][0] = tp_[0]; tq[mm_][1] = tp_[1]; } } while (0)
            RP_TLOAD(0);
#pragma unroll
            for (int ai = 0; ai < 2; ++ai)
#pragma unroll
                for (int mp = 0; mp < 2; ++mp)
#pragma unroll
                    for (int bj = 0; bj < 2; ++bj) {
                        const int dim0 = 128 * bj + cl;
                        float rz[2][8];
                        const f32x4 tc[2][2] = {{tq[0][0], tq[0][1]}, {tq[1][0], tq[1][1]}};
                        if ((ai * 2 + mp) * 2 + bj + 1 < 8) RP_TLOAD((ai * 2 + mp) * 2 + bj + 1);
#pragma unroll
                        for (int mm = 0; mm < 2; ++mm) {
                            const int m = 2 * mp + mm, row = row0 + ai * HALF + m * 16;
                            const float zeta = __builtin_amdgcn_exp2f(l2g * (float)(127 - (row & 127)));
                            const f32x4 t0 = tc[mm][0], t1 = tc[mm][1];
                            const f32x4 a0 = acc[ai][bj][m][0], a1 = acc[ai][bj][m][1];
                            f32x4 r0, r1;
                            r0[0] = a0[0] * t0[0] - a0[1] * t0[1]; r0[1] = a0[1] * t0[0] + a0[0] * t0[1];
                            r0[2] = a0[2] * t0[2] - a0[3] * t0[3]; r0[3] = a0[3] * t0[2] + a0[2] * t0[3];
                            r1[0] = a1[0] * t1[0] - a1[1] * t1[1]; r1[1] = a1[1] * t1[0] + a1[0] * t1[1];
                            r1[2] = a1[2] * t1[2] - a1[3] * t1[3]; r1[3] = a1[3] * t1[2] + a1[2] * t1[3];
                            r0 = r0 * sc; r1 = r1 * sc;
                            *(u32x4*)(dst + qk_off(row, h, dim0)) = pack8(r0, r1);
#pragma unroll
                            for (int j = 0; j < 4; ++j) { rz[mm][j] = r0[j] * zeta; rz[mm][4 + j] = r1[j] * zeta; }
                        }
                        if (isk) {
                            const int tok0 = row0 - fr + ai * HALF + 32 * mp;
#pragma unroll
                            for (int n = 0; n < 2; ++n) {
                                float ea[4] = {rz[0][4 * n], rz[0][4 * n + 1], rz[0][4 * n + 2], rz[0][4 * n + 3]}, oa[4] = {rz[1][4 * n], rz[1][4 * n + 1], rz[1][4 * n + 2], rz[1][4 * n + 3]};
                                quad_tr(ea, o1, o2); quad_tr(oa, o1, o2);
                                const int rr = 256 * h + dim0 + 4 * n + rl;
                                u32x4 w; w.x = cvt_pk_bf16(ea[0], ea[1]); w.y = cvt_pk_bf16(ea[2], ea[3]); w.z = cvt_pk_bf16(oa[0], oa[1]); w.w = cvt_pk_bf16(oa[2], oa[3]);
                                *(u32x4*)(KZT + ((((size_t)(rr >> 4) * 512 + (tok0 >> 5)) * 64) + (rr & 15) + 16 * qd) * 8) = w;
                            }
                        }
                    }
#undef RP_TLOAD
        } else if (pn < 32) {
#pragma unroll
            for (int ai = 0; ai < 2; ++ai)
#pragma unroll
                for (int mp = 0; mp < 2; ++mp)
#pragma unroll
                    for (int bj = 0; bj < 2; ++bj) {
                        const int tok0 = row0 - fr + ai * HALF + 32 * mp, c0 = (pn - 16) * 256 + 128 * bj + cl;
#pragma unroll
                        for (int n = 0; n < 2; ++n) {
                            float ea[4] = {acc[ai][bj][2 * mp][n][0], acc[ai][bj][2 * mp][n][1], acc[ai][bj][2 * mp][n][2], acc[ai][bj][2 * mp][n][3]};
                            float oa[4] = {acc[ai][bj][2 * mp + 1][n][0], acc[ai][bj][2 * mp + 1][n][1], acc[ai][bj][2 * mp + 1][n][2], acc[ai][bj][2 * mp + 1][n][3]};
                            quad_tr(ea, o1, o2); quad_tr(oa, o1, o2);
                            const int rr = c0 + 4 * n + rl;
                            u32x4 w; w.x = cvt_pk_bf16(ea[0], ea[1]); w.y = cvt_pk_bf16(ea[2], ea[3]); w.z = cvt_pk_bf16(oa[0], oa[1]); w.w = cvt_pk_bf16(oa[2], oa[3]);
                            *(u32x4*)(VT + ((((size_t)(rr >> 4) * 512 + (tok0 >> 5)) * 64) + (rr & 15) + 16 * qd) * 8) = w;
                        }
                    }
        } else {
#pragma unroll
            for (int ai = 0; ai < 2; ++ai)
#pragma unroll
                for (int m = 0; m < 4; ++m) {
                    const int row = row0 + ai * HALF + m * 16;
#pragma unroll
                    for (int bj = 0; bj < 2; ++bj) { f32x4 v0, v1;
#pragma unroll
                        for (int j = 0; j < 4; j += 2) { const f32x2 a = silu2_mul((f32x2){acc[ai][bj][m][0][j], acc[ai][bj][m][0][j + 1]}, (f32x2){1.0f, 1.0f}), b = silu2_mul((f32x2){acc[ai][bj][m][1][j], acc[ai][bj][m][1][j + 1]}, (f32x2){1.0f, 1.0f});
                            v0[j] = a.x; v0[j + 1] = a.y; v1[j] = b.x; v1[j + 1] = b.y; }
                        *(u32x4*)(GS + (size_t)row * 4096 + (pn - 32) * 256 + 128 * bj + cl) = pack8(v0, v1); }
                }
        }
    }
};
template <class Epi, class Sched, bool ALIGN_EPI = false, bool SP2 = false>
__device__ __forceinline__ void gemm_phase(PG8_LAS unsigned char* lds, const Gemm g, const Sched& S, const Epi& E) {
    int tid_ = threadIdx.x; asm volatile("" : "+v"(tid_));
    const int tid = tid_, wid = __builtin_amdgcn_readfirstlane(tid >> 6), lane = tid & 63, wr = wid >> 2, wc = wid & 3, fr = lane & 15, fq = lane >> 4;
    const int K = g.K, nt = K / BK;
    unsigned voffA[2], voffB[2];
#pragma unroll
    for (int i = 0; i < 2; ++i) { int R, C; stage_rc(tid * 16 + i * 8192, R, C); const int Rb = Epi::PERM ? ((R & ~31) + perm32(R & 31)) : R;
        voffA[i] = (unsigned)(R * K + C) * 2u; voffB[i] = (unsigned)(Rb * K + C) * 2u; }
    const size_t kstep = (size_t)(BK * 2);
    const size_t hstep = (size_t)HALF * K * 2;
    const size_t tstep = 2 * hstep;
    const unsigned ldsw = (unsigned)wid * 1024u;
    const int aoff = lds_byte(wr * 64 + fr, fq * 8), boff = lds_byte(wc * 32 + fr, fq * 8);
#define PG8_SA(b, h) (((b) * 2 + (h)) * HTB)
#define PG8_SB(b, h) ((4 + (b) * 2 + (h)) * HTB)
#define PG8_STAGE(bufoff, gbase, voff) do { _Pragma("unroll") for (int _i = 0; _i < 2; ++_i) \
        __builtin_amdgcn_global_load_lds((const unsigned*)((const char*)(gbase) + (voff)[_i]), (PG8_LAS unsigned*)(lds + (bufoff) + ldsw + _i * 8192), 16, 0, 0); } while (0)
#define PG8_LDA(dst, b, h) do { _Pragma("unroll") for (int m = 0; m < 4; ++m) _Pragma("unroll") for (int k = 0; k < 2; ++k) dst[m][k] = *(const PG8_LAS bf16x8*)(lds + PG8_SA(b, h) + aoff + m * 2048 + k * 1024); } while (0)
#define PG8_LDB(dst, b, h) do { _Pragma("unroll") for (int n = 0; n < 2; ++n) _Pragma("unroll") for (int k = 0; k < 2; ++k) dst[n][k] = *(const PG8_LAS bf16x8*)(lds + PG8_SB(b, h) + boff + n * 2048 + k * 1024); } while (0)
#define PG8_MMA(ai, bj, At, Bt) do { __builtin_amdgcn_s_setprio(1); _Pragma("unroll") for (int m = 0; m < 4; ++m) _Pragma("unroll") for (int n = 0; n < 2; ++n) _Pragma("unroll") for (int k = 0; k < 2; ++k) \
        acc[ai][bj][m][n] = __builtin_amdgcn_mfma_f32_16x16x32_bf16(Bt[n][k], At[m][k], acc[ai][bj][m][n], 0, 0, 0); __builtin_amdgcn_s_setprio(0); } while (0)
#define PG8_WAIT_V(n) asm volatile("s_waitcnt vmcnt(" #n ")" ::: "memory")
#define PG8_WAIT_L(n) asm volatile("s_waitcnt lgkmcnt(" #n ")" ::: "memory")
#define PG8_BAR __builtin_amdgcn_s_barrier()
#define PG8_SCHED __builtin_amdgcn_sched_barrier(0)
    Unit cur, nxt; int ui = 0;
    if (!S.next(0, cur)) return;
    f32x4 acc[2][2][4][2];
#pragma unroll
    for (int a = 0; a < 2; ++a)
#pragma unroll
        for (int b = 0; b < 2; ++b)
#pragma unroll
            for (int m = 0; m < 4; ++m)
#pragma unroll
                for (int n = 0; n < 2; ++n) acc[a][b][m][n] = (f32x4){0.f, 0.f, 0.f, 0.f};
    bf16x8 At[4][2], B0[2][2], B1[2][2];
    const char* cA = (const char*)g.A + (size_t)cur.pm * tstep; const char* cB = (const char*)g.Bt + (size_t)cur.pn * tstep;
    S.a_ready(cur);
    if constexpr (SP2) {
        PG8_STAGE(PG8_SB(0, 0), cB, voffB); PG8_STAGE(PG8_SB(0, 1), cB + hstep, voffB); PG8_STAGE(PG8_SA(0, 0), cA, voffA); PG8_STAGE(PG8_SA(0, 1), cA + hstep, voffA);
        if (wr == 1) PG8_BAR;
        PG8_WAIT_V(2); PG8_BAR;
        PG8_STAGE(PG8_SB(1, 0), cB + kstep, voffB); PG8_STAGE(PG8_SA(1, 0), cA + kstep, voffA); PG8_STAGE(PG8_SB(1, 1), cB + hstep + kstep, voffB);
        PG8_WAIT_V(6); PG8_BAR;
    } else {
        PG8_STAGE(PG8_SB(0, 0), cB, voffB); PG8_STAGE(PG8_SA(0, 0), cA, voffA); PG8_STAGE(PG8_SB(0, 1), cB + hstep, voffB); PG8_STAGE(PG8_SA(0, 1), cA + hstep, voffA);
        if (wr == 1) PG8_BAR;
        PG8_WAIT_V(4); PG8_BAR;
        PG8_STAGE(PG8_SB(1, 0), cB + kstep, voffB); PG8_STAGE(PG8_SA(1, 0), cA + kstep, voffA); PG8_STAGE(PG8_SB(1, 1), cB + hstep + kstep, voffB);
        PG8_WAIT_V(6); PG8_BAR;
    }
    for (;;) {
        const bool has_next = S.next(ui + 1, nxt);
        const char* nA = has_next ? (const char*)g.A + (size_t)nxt.pm * tstep : cA; const char* nB = has_next ? (const char*)g.Bt + (size_t)nxt.pn * tstep : cB;
        for (int t = 0; t < nt; t += 2) {
            const bool last = (t == nt - 2);
            const char* a1 = cA + (size_t)(t + 1) * kstep;
            const char* a2 = last ? nA : cA + (size_t)(t + 2) * kstep; const char* b2 = last ? nB : cB + (size_t)(t + 2) * kstep;
            const char* a3 = a2 + kstep; const char* b3 = b2 + kstep;
            if (last && has_next) S.a_ready(nxt);
            if constexpr (SP2) {
            PG8_LDB(B0, 0, 0); PG8_LDB(B1, 0, 1); PG8_SCHED; PG8_LDA(At, 0, 0); PG8_STAGE(PG8_SA(1, 1), a1 + hstep, voffA);
            PG8_WAIT_V(8); PG8_WAIT_L(0); PG8_BAR; PG8_MMA(0, 0, At, B0); PG8_MMA(0, 1, At, B1); PG8_BAR; PG8_SCHED;
            PG8_LDA(At, 0, 1); PG8_STAGE(PG8_SB(0, 0), b2, voffB); PG8_STAGE(PG8_SB(0, 1), b2 + hstep, voffB); PG8_STAGE(PG8_SA(0, 0), a2, voffA);
            PG8_WAIT_V(8); PG8_WAIT_L(0); PG8_BAR; PG8_MMA(1, 0, At, B0); PG8_MMA(1, 1, At, B1); PG8_BAR; PG8_SCHED;
            PG8_LDB(B0, 1, 0); PG8_LDB(B1, 1, 1); PG8_SCHED; PG8_LDA(At, 1, 0); PG8_STAGE(PG8_SA(0, 1), a2 + hstep, voffA);
            PG8_WAIT_V(8); PG8_WAIT_L(0); PG8_BAR; PG8_MMA(0, 0, At, B0); PG8_MMA(0, 1, At, B1); PG8_BAR; PG8_SCHED;
            PG8_LDA(At, 1, 1); PG8_STAGE(PG8_SB(1, 0), b3, voffB); PG8_STAGE(PG8_SB(1, 1), b3 + hstep, voffB); PG8_STAGE(PG8_SA(1, 0), a3, voffA);
            PG8_WAIT_V(8); PG8_WAIT_L(0); PG8_BAR; PG8_MMA(1, 0, At, B0); PG8_MMA(1, 1, At, B1); PG8_BAR; PG8_SCHED;
            } else {
            PG8_LDB(B0, 0, 0); PG8_SCHED; PG8_LDA(At, 0, 0); PG8_STAGE(PG8_SA(1, 1), a1 + hstep, voffA);
            PG8_WAIT_L(8); PG8_BAR; PG8_WAIT_L(0); PG8_MMA(0, 0, At, B0); PG8_BAR; PG8_SCHED;
            PG8_LDB(B1, 0, 1); PG8_STAGE(PG8_SB(0, 0), b2, voffB);
            PG8_BAR; PG8_WAIT_L(0); PG8_MMA(0, 1, At, B1); PG8_BAR;
            PG8_LDA(At, 0, 1); PG8_STAGE(PG8_SA(0, 0), a2, voffA);
            PG8_BAR; PG8_WAIT_L(0); PG8_MMA(1, 0, At, B0); PG8_BAR; PG8_SCHED;
            PG8_STAGE(PG8_SB(0, 1), b2 + hstep, voffB);
            PG8_WAIT_V(6); PG8_BAR; PG8_MMA(1, 1, At, B1); PG8_BAR;
            PG8_LDB(B0, 1, 0); PG8_SCHED; PG8_LDA(At, 1, 0); PG8_STAGE(PG8_SA(0, 1), a2 + hstep, voffA);
            PG8_WAIT_L(8); PG8_BAR; PG8_WAIT_L(0); PG8_MMA(0, 0, At, B0); PG8_BAR; PG8_SCHED;
            PG8_LDB(B1, 1, 1); PG8_STAGE(PG8_SB(1, 0), b3, voffB);
            PG8_BAR; PG8_WAIT_L(0); PG8_MMA(0, 1, At, B1); PG8_BAR;
            PG8_LDA(At, 1, 1); PG8_STAGE(PG8_SA(1, 0), a3, voffA);
            PG8_BAR; PG8_WAIT_L(0); PG8_MMA(1, 0, At, B0); PG8_BAR; PG8_SCHED;
            PG8_STAGE(PG8_SB(1, 1), b3 + hstep, voffB);
            PG8_WAIT_V(6); PG8_BAR; PG8_MMA(1, 1, At, B1); PG8_BAR;
            }
        }
        if constexpr (ALIGN_EPI) { if (wr == 0) PG8_BAR; }
        if constexpr (!Epi::AFTER_DRAIN) { E(acc, cur, wr, wc, fr, fq); S.done(cur); }
        if (!has_next) break;
#pragma unroll
        for (int a = 0; a < 2; ++a)
#pragma unroll
            for (int b = 0; b < 2; ++b)
#pragma unroll
                for (int m = 0; m < 4; ++m)
#pragma unroll
                    for (int n = 0; n < 2; ++n) acc[a][b][m][n] = (f32x4){0.f, 0.f, 0.f, 0.f};
        cur = nxt; cA = nA; cB = nB; ++ui;
        if constexpr (ALIGN_EPI) { if (wr == 1) PG8_BAR; }
    }
    PG8_WAIT_V(0);
    if constexpr (!ALIGN_EPI) { if (wr == 0) PG8_BAR; }
    PG8_BAR;
    if constexpr (Epi::AFTER_DRAIN) { E.fused(acc, cur, wr, wc, fr, fq, lds, wid, lane); S.done(cur); }
#undef PG8_SA
#undef PG8_SB
#undef PG8_STAGE
#undef PG8_LDA
#undef PG8_LDB
#undef PG8_MMA
#undef PG8_WAIT_V
#undef PG8_WAIT_L
#undef PG8_BAR
#undef PG8_SCHED
}
}

#ifndef PG8_SP2
#define PG8_SP2 true
#endif
#ifndef PG8_ALIGN
#define PG8_ALIGN true
#endif
#include <hip/hip_bf16.h>
#include <cmath>
namespace attn_body {
using bf16=__hip_bfloat16;
using bf16x8=__attribute__((ext_vector_type(8)))short;
using s16x4=__attribute__((ext_vector_type(4)))short;
using f32x16=__attribute__((ext_vector_type(16)))float;
using u32x4=__attribute__((ext_vector_type(4)))unsigned;
constexpr int BATCH=1,NHEAD=32,SEQ=16384,D=64,DM=NHEAD*D;
constexpr int NW=8,QBLK=32,QB=QBLK*NW,KVBLK=64,NQB=SEQ/QB;
constexpr int ATTN_PITCH=DM, ATTN_UNIT_ROWS=QB;
__device__ __forceinline__ int crow(int r,int hi){return (r&3)+8*(r>>2)+4*hi;}
#define SBAR() __builtin_amdgcn_sched_barrier(0)
__device__ __forceinline__ void cmask(f32x16&p0,f32x16&p1,int jb,int qrel,int hi){
  const float NEG=-INFINITY; int kb=64*jb+4*hi;
  #pragma unroll
  for(int r=0;r<16;++r){int kv=kb+(r&3)+8*(r>>2); if(kv>qrel)p0[r]=NEG; if(kv+32>qrel)p1[r]=NEG;}
}

constexpr int NSLOT=3, SLOTB=8192;
constexpr int LDS_K=0, LDS_V=NSLOT*SLOTB, LDS_WS=2*NSLOT*SLOTB, LDS_OST=LDS_WS+NW*64*4, LDS_BYTES=LDS_OST+NW*4096;
constexpr float C2=0.125f*1.4426950408889634f;
__device__ __forceinline__ void glds16(const void*gsrc,unsigned lds_dst){unsigned keep;
  asm volatile("s_mov_b32 %0, m0\n\ts_mov_b32 m0, %2\n\ts_nop 0\n\tglobal_load_lds_dwordx4 %1, off\n\ts_mov_b32 m0, %0":"=&s"(keep):"v"(gsrc),"s"(lds_dst):"memory");}
__device__ __forceinline__ float max3f(float a,float b,float c){float r;asm("v_max3_f32 %0, %1, %2, %3":"=v"(r):"v"(a),"v"(b),"v"(c));return r;}
__device__ __forceinline__ float max2f(float a,float b){float r;asm("v_max_f32_e32 %0, %1, %2":"=v"(r):"v"(a),"v"(b));return r;}
__device__ __forceinline__ float fadd_s(float a,float b){float r;asm("v_add_f32_e32 %0, %1, %2":"=v"(r):"v"(a),"v"(b));return r;}
__device__ __forceinline__ float fsub_s(float a,float b){float r;asm("v_sub_f32_e32 %0, %1, %2":"=v"(r):"v"(a),"v"(b));return r;}
typedef float f32x2_t __attribute__((ext_vector_type(2))); typedef __bf16 bf16x2_t __attribute__((ext_vector_type(2)));
__device__ __forceinline__ unsigned cvtpk_s(float lo,float hi){f32x2_t v={lo,hi};bf16x2_t b=__builtin_convertvector(v,bf16x2_t);return __builtin_bit_cast(unsigned,b);}
#define WAIT_BAR(N) asm volatile("s_waitcnt vmcnt(" #N ") lgkmcnt(0)\n\ts_barrier":::"memory")

__device__ __forceinline__ void qkt(f32x16&p0,f32x16&p1,const char*Kslot,const bf16x8*qr,const f32x16&negm,int r32,int hi){
  const char*kb=Kslot+hi*1024+r32*16;
  #pragma unroll
  for(int d0=0;d0<4;++d0){
    const bf16x8 b0=*reinterpret_cast<const bf16x8*>(kb+d0*2048);
    const bf16x8 b1=*reinterpret_cast<const bf16x8*>(kb+d0*2048+512);
    if(d0==0){p0=__builtin_amdgcn_mfma_f32_32x32x16_bf16(b0,qr[0],negm,0,0,0);p1=__builtin_amdgcn_mfma_f32_32x32x16_bf16(b1,qr[0],negm,0,0,0);}
    else{p0=__builtin_amdgcn_mfma_f32_32x32x16_bf16(b0,qr[d0],p0,0,0,0);p1=__builtin_amdgcn_mfma_f32_32x32x16_bf16(b1,qr[d0],p1,0,0,0);}}
}
typedef __attribute__((address_space(3))) const char* lds_cptr;
typedef short v4i16_t __attribute__((ext_vector_type(4)));
__device__ __forceinline__ void kload8(bf16x8*kf,lds_cptr kp){
  kf[0]=*(const __attribute__((address_space(3))) bf16x8*)(kp);      kf[1]=*(const __attribute__((address_space(3))) bf16x8*)(kp+512);
  kf[2]=*(const __attribute__((address_space(3))) bf16x8*)(kp+2048); kf[3]=*(const __attribute__((address_space(3))) bf16x8*)(kp+2560);
  kf[4]=*(const __attribute__((address_space(3))) bf16x8*)(kp+4096); kf[5]=*(const __attribute__((address_space(3))) bf16x8*)(kp+4608);
  kf[6]=*(const __attribute__((address_space(3))) bf16x8*)(kp+6144); kf[7]=*(const __attribute__((address_space(3))) bf16x8*)(kp+6656);
}
__device__ __forceinline__ void kload2(bf16x8*kf,lds_cptr kp,int j){ kf[2*j]=*(const __attribute__((address_space(3))) bf16x8*)(kp+j*2048); kf[2*j+1]=*(const __attribute__((address_space(3))) bf16x8*)(kp+j*2048+512); }
__device__ __forceinline__ s16x4 vtr(lds_cptr p){ return __builtin_bit_cast(s16x4,__builtin_amdgcn_ds_read_tr16_b64_v4i16((__attribute__((address_space(3))) v4i16_t*)p)); }
__device__ __forceinline__ float rowmax(const f32x16&p0,const f32x16&p1){
  float a=max3f(p0[0],p0[1],p1[0]),b=max3f(p0[2],p0[3],p1[1]);a=max3f(a,p1[2],p1[3]);
  #pragma unroll
  for(int r=4;r<16;r+=4){a=max3f(a,p0[r],p0[r+1]);b=max3f(b,p0[r+2],p0[r+3]);a=max3f(a,p1[r],p1[r+1]);b=max3f(b,p1[r+2],p1[r+3]);}
  const float m=max2f(a,b);
  auto rr=__builtin_amdgcn_permlane32_swap(__float_as_uint(m),__float_as_uint(m),false,false);
  return max2f(__uint_as_float(rr[0]),__uint_as_float(rr[1]));
}
__device__ __forceinline__ void pv(f32x16*o,int vb,bf16x8 pa0,bf16x8 pa1,bf16x8 pa2,bf16x8 pa3){
  #pragma unroll
  for(int d0=0;d0<2;++d0){s16x4 lo[4],hi[4];
    #pragma unroll
    for(int ks=0;ks<4;++ks){
      asm volatile("ds_read_b64_tr_b16 %0,%1 offset:%c2":"=&v"(lo[ks]):"v"(vb),"i"(d0*4096+ks*1024):"memory");
      asm volatile("ds_read_b64_tr_b16 %0,%1 offset:%c2":"=&v"(hi[ks]):"v"(vb),"i"(d0*4096+ks*1024+512):"memory");}
    asm volatile("s_waitcnt lgkmcnt(0)":::"memory");SBAR();
    #define PK(k) (bf16x8){lo[k][0],lo[k][1],lo[k][2],lo[k][3],hi[k][0],hi[k][1],hi[k][2],hi[k][3]}
    o[d0]=__builtin_amdgcn_mfma_f32_32x32x16_bf16(pa0,PK(0),o[d0],0,0,0);
    o[d0]=__builtin_amdgcn_mfma_f32_32x32x16_bf16(pa1,PK(1),o[d0],0,0,0);
    o[d0]=__builtin_amdgcn_mfma_f32_32x32x16_bf16(pa2,PK(2),o[d0],0,0,0);
    o[d0]=__builtin_amdgcn_mfma_f32_32x32x16_bf16(pa3,PK(3),o[d0],0,0,0);
    #undef PK
  }
}

#ifndef ATTN_STORE16
#define ATTN_STORE16(p,v) (*(u32x4*)(p)=(v))
#endif
template<int THRL> __device__ __forceinline__ void attn_unit(int qh,int vh,int qb,const bf16*Q,const bf16*__restrict__ K,const bf16*__restrict__ V,bf16*O,char*shm){
  int tid_=threadIdx.x; asm volatile("":"+v"(tid_));
  const int tid=tid_,lane=tid&63,r32=lane&31,hi=lane>>5; const int wid=__builtin_amdgcn_readfirstlane(tid>>6);
  const long rowbase=0; const int q0=qb*QB;
  const bf16*Qw=Q+(rowbase+q0+wid*QBLK)*DM+qh*D;
  const bf16*Kh=K+rowbase*DM+qh*D,*Vh=V+rowbase*DM+vh*D;
  const unsigned lds0=(unsigned)(uintptr_t)shm;
  float*wsf=(float*)(shm+LDS_WS)+wid*64;
  const bf16*ksrc=Kh+(long)lane*DM+wid*8;
  const bf16*vsrc=Vh+(long)(16*(wid&3)+(lane>>2))*DM+(wid>>2)*32+(lane&3)*8;
  const unsigned kdst=lds0+LDS_K+wid*1024, vdst=lds0+LDS_V+wid*1024;
  #define DMA_K(t,slot) glds16(ksrc+(long)(t)*KVBLK*DM,(unsigned)__builtin_amdgcn_readfirstlane(kdst+(slot)))
  #define DMA_V(t,slot) glds16(vsrc+(long)(t)*KVBLK*DM,(unsigned)__builtin_amdgcn_readfirstlane(vdst+(slot)))
  const int vb0=(int)(lds0+LDS_V)+((lane>>4)&1)*32+(lane&3)*8+(4*hi+((lane&15)>>2))*64;
  const char*Kbase=shm+LDS_K; bf16x8 kf[8];
  const lds_cptr shm3=(lds_cptr)shm; const lds_cptr kp0=shm3+LDS_K+hi*1024+r32*16; const lds_cptr vp0=shm3+LDS_V+((lane>>4)&1)*32+(lane&3)*8+(4*hi+((lane&15)>>2))*64;
  const int NT=(q0+QB)/KVBLK;
  DMA_K(0,0);DMA_V(0,0);DMA_K(1,SLOTB);
  bf16x8 qr[4];
  #pragma unroll
  for(int d0=0;d0<4;++d0)qr[d0]=*reinterpret_cast<const bf16x8*>(&Qw[(long)r32*DM+d0*16+hi*8]);
  float mhat=0.f,l_reg=0.f;f32x16 o[2];o[0]=f32x16{};o[1]=f32x16{};f32x16 negm=f32x16{};asm volatile("":"+v"(negm));
  const int qrel=wid*QBLK+r32;
  #define CMASK(P0,P1,t) do{int jb_=(t)-(NT-4); if(jb_>=0)cmask(P0,P1,jb_,qrel,hi);}while(0)
  bool resc=false;
  #define START(P0,P1) do{ const float rm=rowmax(P0,P1); resc=false; \
    { const float dl=rm; mhat=fadd_s(mhat,dl); \
      _Pragma("unroll") for(int r=0;r<16;++r){P0[r]=fsub_s(P0[r],dl);P1[r]=fsub_s(P1[r],dl);} \
      _Pragma("unroll") for(int r=0;r<16;++r)negm[r]=-mhat; asm volatile("":"+v"(negm)); } \
    _Pragma("unroll") for(int r=0;r<16;++r)P0[r]=__builtin_amdgcn_exp2f(P0[r]); }while(0)
  #define RESC() do{ if(resc){ asm volatile("s_waitcnt lgkmcnt(0)":::"memory"); \
      _Pragma("unroll") for(int d_=0;d_<2;++d_) _Pragma("unroll") for(int r=0;r<16;++r)o[d_][r]*=wsf[crow(r,hi)]; } }while(0)
  f32x16 pA0,pA1,pB0,pB1;
  int sl_prev=0,sl_cur=0,sl_next=SLOTB;
  #define ROT() do{sl_prev=sl_cur;sl_cur=sl_next;sl_next=(sl_next==(NSLOT-1)*SLOTB)?0:sl_next+SLOTB;}while(0)
  DMA_K(2,2*SLOTB);
  WAIT_BAR(3);
  qkt(pA0,pA1,Kbase,qr,negm,r32,hi);asm volatile("s_nop 15\n\ts_nop 7":"+v"(pA0),"+v"(pA1));CMASK(pA0,pA1,0);
  START(pA0,pA1);
  _Pragma("unroll") for(int r=0;r<16;++r)pA1[r]=__builtin_amdgcn_exp2f(pA1[r]);
  WAIT_BAR(0);
  DMA_K(3,0);DMA_V(1,SLOTB);
  ROT();
  kload8(kf,kp0+sl_cur);
  WAIT_BAR(2);
  s16x4 vlo[8],vhi[8]; u32x4 pw0,pw1,pw2,pw3;
  #define PKW(P,B) cvtpk_s(P[B],P[B+1])
  #define PAF(k) __builtin_bit_cast(bf16x8,pw##k)
  #define VFR(i) (bf16x8){vlo[i][0],vlo[i][1],vlo[i][2],vlo[i][3],vhi[i][0],vhi[i][1],vhi[i][2],vhi[i][3]}
  #define PIN(x) asm volatile("":"+v"(x))
  #define MX3(a,b,c) __builtin_fmaxf(__builtin_fmaxf((a),(b)),(c))
  #define GAPA(MF,A0,A1,A2,A3,W0,W1,PW) do{ MF; sacc+=A0; sacc+=A1; sacc+=A2; sacc+=A3; PIN(sacc); W0; W1; PIN(PW); SBAR(); }while(0)
  #define EX(v) __builtin_amdgcn_exp2f(v)
  #define GAPB(MF,X,B) do{ MF; X[B]=EX(X[B]); X[B+1]=EX(X[B+1]); X[B+2]=EX(X[B+2]); X[B+3]=EX(X[B+3]); PIN(X); SBAR(); }while(0)
  #define VRD(i) do{ vlo[i]=vtr(vp_+(((i)>>2)*4096+((i)&3)*1024)); vhi[i]=vtr(vp_+(((i)>>2)*4096+((i)&3)*1024+512)); }while(0)
  #define KRD(G,j) do{ if(G){ kload2(kf,kp0+sl_next,j); SBAR(); } }while(0)
  #define STEP(C0,C1,P0,P1,t,GK,GV,GL) do{ SBAR(); \
    const lds_cptr vp_=vp0+sl_prev; \
    VRD(0); SBAR(); float sacc=(P0[0]+P0[1]); \
    GAPA(C0=__builtin_amdgcn_mfma_f32_32x32x16_bf16(kf[0],qr[0],negm,0,0,0), P0[2],P0[3],P0[4],P0[5],     pw0[0]=PKW(P0,0), pw0[1]=PKW(P0,2), pw0); \
    VRD(4); SBAR(); GAPA(C1=__builtin_amdgcn_mfma_f32_32x32x16_bf16(kf[1],qr[0],negm,0,0,0), P0[6],P0[7],P0[8],P0[9],     pw0[2]=PKW(P0,4), pw0[3]=PKW(P0,6), pw0); \
    VRD(1); SBAR(); GAPA(C0=__builtin_amdgcn_mfma_f32_32x32x16_bf16(kf[2],qr[1],C0,0,0,0),   P0[10],P0[11],P0[12],P0[13], pw1[0]=PKW(P0,8), pw1[1]=PKW(P0,10), pw1); \
    VRD(5); SBAR(); GAPA(C1=__builtin_amdgcn_mfma_f32_32x32x16_bf16(kf[3],qr[1],C1,0,0,0),   P0[14],P0[15],P1[0],P1[1],   pw1[2]=PKW(P0,12),pw1[3]=PKW(P0,14), pw1); \
    VRD(2); SBAR(); GAPA(C0=__builtin_amdgcn_mfma_f32_32x32x16_bf16(kf[4],qr[2],C0,0,0,0),   P1[2],P1[3],P1[4],P1[5],     pw2[0]=PKW(P1,0), pw2[1]=PKW(P1,2), pw2); \
    VRD(6); SBAR(); GAPA(C1=__builtin_amdgcn_mfma_f32_32x32x16_bf16(kf[5],qr[2],C1,0,0,0),   P1[6],P1[7],P1[8],P1[9],     pw2[2]=PKW(P1,4), pw2[3]=PKW(P1,6), pw2); \
    VRD(3); SBAR(); GAPA(C0=__builtin_amdgcn_mfma_f32_32x32x16_bf16(kf[6],qr[3],C0,0,0,0),   P1[10],P1[11],P1[12],P1[13], pw3[0]=PKW(P1,8), pw3[1]=PKW(P1,10), pw3); \
    VRD(7); SBAR(); GAPA(C1=__builtin_amdgcn_mfma_f32_32x32x16_bf16(kf[7],qr[3],C1,0,0,0),   P1[14],P1[15],0.f,0.f,       pw3[2]=PKW(P1,12),pw3[3]=PKW(P1,14), pw3); \
    l_reg+=sacc; \
    if(GK){DMA_K((t)+3,sl_cur);} if(GV){DMA_V((t)+1,sl_next);} \
    CMASK(C0,C1,t); \
    { float a=MX3(C0[0],C0[1],C1[0]),b=MX3(C0[2],C0[3],C1[1]); a=MX3(a,C1[2],C1[3]); \
      _Pragma("unroll") for(int r=4;r<16;r+=4){a=MX3(a,C0[r],C0[r+1]);b=MX3(b,C0[r+2],C0[r+3]);a=MX3(a,C1[r],C1[r+1]);b=MX3(b,C1[r+2],C1[r+3]);} \
      float rm=__builtin_fmaxf(a,b); { auto rr=__builtin_amdgcn_permlane32_swap(__float_as_uint(rm),__float_as_uint(rm),false,false); rm=__builtin_fmaxf(__uint_as_float(rr[0]),__uint_as_float(rr[1])); } \
      resc=false; \
      if(__builtin_expect(__any(rm>(float)THRL),0)){ const float dl=__builtin_fmaxf(rm,0.f); mhat+=dl; \
        _Pragma("unroll") for(int r=0;r<16;++r){C0[r]-=dl;C1[r]-=dl;} \
        _Pragma("unroll") for(int r=0;r<16;++r)negm[r]=-mhat; asm volatile("":"+v"(negm)); \
        const float f=__builtin_amdgcn_exp2f(-dl); l_reg*=f; if(hi==0)wsf[r32]=f; resc=true; } } \
    SBAR(); \
    GAPB(o[0]=__builtin_amdgcn_mfma_f32_32x32x16_bf16(PAF(0),VFR(0),o[0],0,0,0), C0,0); \
    GAPB(o[1]=__builtin_amdgcn_mfma_f32_32x32x16_bf16(PAF(0),VFR(4),o[1],0,0,0), C0,4); \
    KRD(GL,0); GAPB(o[0]=__builtin_amdgcn_mfma_f32_32x32x16_bf16(PAF(1),VFR(1),o[0],0,0,0), C0,8); \
    KRD(GL,1); GAPB(o[1]=__builtin_amdgcn_mfma_f32_32x32x16_bf16(PAF(1),VFR(5),o[1],0,0,0), C0,12); \
    KRD(GL,2); GAPB(o[0]=__builtin_amdgcn_mfma_f32_32x32x16_bf16(PAF(2),VFR(2),o[0],0,0,0), C1,0); \
    KRD(GL,3); GAPB(o[1]=__builtin_amdgcn_mfma_f32_32x32x16_bf16(PAF(2),VFR(6),o[1],0,0,0), C1,4); \
    GAPB(o[0]=__builtin_amdgcn_mfma_f32_32x32x16_bf16(PAF(3),VFR(3),o[0],0,0,0), C1,8); \
    GAPB(o[1]=__builtin_amdgcn_mfma_f32_32x32x16_bf16(PAF(3),VFR(7),o[1],0,0,0), C1,12); \
    }while(0)
  int t=1;
  #undef CMASK
  #define CMASK(P0,P1,t) do{}while(0)
  for(;t+5<NT;t+=2){
    STEP(pB0,pB1,pA0,pA1,t,true,true,true);     WAIT_BAR(2); RESC(); ROT();
    STEP(pA0,pA1,pB0,pB1,t+1,true,true,true);   WAIT_BAR(2); RESC(); ROT();
  }
  #undef CMASK
  #define CMASK(P0,P1,t) do{int jb_=(t)-(NT-4); if(jb_>=0)cmask(P0,P1,jb_,qrel,hi);}while(0)
  #define ENDW(tt) do{ if((tt)+3<NT){WAIT_BAR(2);} else if((tt)+2<NT){WAIT_BAR(1);} else {WAIT_BAR(0);} }while(0)
  for(;t+1<NT;t+=2){
    STEP(pB0,pB1,pA0,pA1,t,(t+3<NT),(t+1<NT),(t+1<NT));       ENDW(t);   RESC(); ROT();
    STEP(pA0,pA1,pB0,pB1,t+1,(t+4<NT),(t+2<NT),(t+2<NT));     ENDW(t+1); RESC(); ROT();
  }
  STEP(pB0,pB1,pA0,pA1,NT-1,false,false,false); RESC();
  { float sacc=pB0[0]+pB0[1]; _Pragma("unroll") for(int r=2;r<16;++r)sacc+=pB0[r]; _Pragma("unroll") for(int r=0;r<16;++r)sacc+=pB1[r]; l_reg+=sacc;
    pw0=(u32x4){PKW(pB0,0),PKW(pB0,2),PKW(pB0,4),PKW(pB0,6)};pw1=(u32x4){PKW(pB0,8),PKW(pB0,10),PKW(pB0,12),PKW(pB0,14)};pw2=(u32x4){PKW(pB1,0),PKW(pB1,2),PKW(pB1,4),PKW(pB1,6)};pw3=(u32x4){PKW(pB1,8),PKW(pB1,10),PKW(pB1,12),PKW(pB1,14)};
    SBAR(); pv(o,vb0+sl_cur,PAF(0),PAF(1),PAF(2),PAF(3)); }
  #undef PKW
  #undef PAF
  #undef VFR
  #undef PIN
  #undef MX3
  #undef GAPA
  #undef GAPB
  #undef EX
  #undef VRD
  #undef KRD
  #undef STEP
  #undef ENDW
  {auto rr=__builtin_amdgcn_permlane32_swap(__float_as_uint(l_reg),__float_as_uint(l_reg),false,false);l_reg=__uint_as_float(rr[0])+__uint_as_float(rr[1]);}
  if(hi==0)wsf[32+r32]=l_reg;asm volatile("s_waitcnt lgkmcnt(0)":::"memory");
  float rli[16];
  #pragma unroll
  for(int r=0;r<16;++r)rli[r]=__builtin_amdgcn_rcpf(wsf[32+crow(r,hi)]);
  bf16*Ow=O+(rowbase+q0+wid*QBLK)*DM+vh*D;
  { bf16*stg=(bf16*)(shm+LDS_OST)+wid*2048;
    #pragma unroll
    for(int r=0;r<16;++r){const int orow=crow(r,hi);
      #pragma unroll
      for(int d0=0;d0<2;++d0)stg[orow*64+d0*32+r32]=__float2bfloat16(o[d0][r]*rli[r]);}
    asm volatile("s_waitcnt lgkmcnt(0)":::"memory");
    #pragma unroll
    for(int i=0;i<4;++i){const int row=i*8+(lane>>3),ch=lane&7; const u32x4 v=*(const u32x4*)(stg+row*64+ch*8); ATTN_STORE16(Ow+(long)row*DM+ch*8,v);} }
  asm volatile("s_waitcnt lgkmcnt(0)\n\ts_barrier":::"memory");
  #undef DMA_K
  #undef DMA_V
  #undef CMASK
  #undef START
  #undef RESC
  #undef ROT
}
constexpr int ATTN_LDS_BYTES=LDS_BYTES;
struct AttnTensors { const bf16* Q; const bf16* K; const bf16* V; bf16* O0; bf16* O1; };
struct AttnUnit { int vv; int qb; };
struct StaticOrder {
  int x, j;
  __device__ __forceinline__ explicit StaticOrder(int vcu):x(vcu>>5),j(vcu&31){}
  __device__ __forceinline__ bool next(int i,AttnUnit&u)const{ if(i>=16)return false; u.vv=x*8+(i>>1); u.qb=(i&1)?63-j:j; return true; }
  __device__ __forceinline__ void a_ready(const AttnUnit&)const{}
  __device__ __forceinline__ void done(const AttnUnit&)const{}
};
template<class Sched,int THRL=8> __device__ __forceinline__ void attn_phase(char*lds,const AttnTensors&T,const Sched&S){
  AttnUnit u;
  for(int i=0;S.next(i,u);++i){ S.a_ready(u); const int h=u.vv>>2,c=(u.vv>>1)&1,jv=u.vv&1; attn_unit<THRL>(2*h+c,2*h+jv,u.qb,T.Q,T.K,T.V,c?T.O1:T.O0,lds); S.done(u); }
}
#undef SBAR
#undef WAIT_BAR
}
namespace da {
using attn_body::bf16; using attn_body::bf16x8; using attn_body::s16x4; using attn_body::f32x16; using attn_body::u32x4;
typedef __attribute__((address_space(3))) const char* lds_cptr;
typedef __attribute__((address_space(3))) char* lds_ptr;
constexpr int SEQ = 16384, PITCH = 2048, QBR = 128, KVB = 64;
constexpr int KSLOT = 16384, VSLOT = 16384, NKS = 3, NVS = 4, LDS_K = 0, LDS_V = NKS * KSLOT, LDS_WS = LDS_V + NVS * VSLOT, LDS_END = LDS_WS + 8 * 256;
constexpr int EP_ROWB = 528, EP_TILE = 32 * EP_ROWB;
static_assert(4 * EP_TILE <= LDS_WS && LDS_END <= 131072, "da LDS map");
__device__ __forceinline__ int crow(int r, int hi) { return (r & 3) + 8 * (r >> 2) + 4 * hi; }
#define DA_WAIT_BAR(N) asm volatile("s_waitcnt vmcnt(" #N ") lgkmcnt(0)\n\ts_barrier" ::: "memory")
#define DA_BAR() asm volatile("s_waitcnt lgkmcnt(0)\n\ts_barrier" ::: "memory")
struct Tensors { const bf16* Q; const bf16* K; const bf16* V; bf16* ON; const float* subg; float lam, post, mb; };

template <bool SHIFT> __device__ __forceinline__ void unit(const Tensors& TT, int h, int qb, char* shm) {
    int tid_ = threadIdx.x; asm volatile("" : "+v"(tid_));
    const int tid = tid_, lane = tid & 63, r32 = lane & 31, hi = lane >> 5; const int wid = __builtin_amdgcn_readfirstlane(tid >> 6);
    const int c = wid >> 2, rg = wid & 3;
    const int q0 = qb * QBR, NT = (q0 + QBR) / KVB;
    const unsigned lds0 = (unsigned)(uintptr_t)shm;
    const lds_cptr shm3 = (lds_cptr)shm;
    const int krow = 8 * wid + (lane >> 3), vrow = 8 * wid + (lane >> 4);
    const bf16* ksrc0 = TT.K + ((long)(2 * h) * SEQ + krow) * 64 + (((lane & 7) ^ ((krow >> 1) & 7)) * 8);
    const bf16* ksrc1 = ksrc0 + (long)SEQ * 64;
    const bf16* vsrcA = TT.V + ((long)h * SEQ + vrow) * 128 + (((lane & 15) ^ (4 * (vrow & 3))) * 8);
    const bf16* vsrcB = vsrcA + 4 * 128;
    const unsigned kdst = lds0 + LDS_K + wid * 1024, vdst = lds0 + LDS_V + wid * 2048;
#define DA_DMA(t, ksl, vsl) do { const long to_ = (long)(t) * KVB * 64; \
        attn_body::glds16(ksrc0 + to_, (unsigned)__builtin_amdgcn_readfirstlane(kdst + (ksl) * KSLOT)); attn_body::glds16(ksrc1 + to_, (unsigned)__builtin_amdgcn_readfirstlane(kdst + (ksl) * KSLOT + 8192)); \
        attn_body::glds16(vsrcA + 2 * to_, (unsigned)__builtin_amdgcn_readfirstlane(vdst + (vsl) * VSLOT)); attn_body::glds16(vsrcB + 2 * to_, (unsigned)__builtin_amdgcn_readfirstlane(vdst + (vsl) * VSLOT + 1024)); } while (0)
    const bf16* Qw = TT.Q + ((long)(2 * h + c) * SEQ + q0 + rg * 32) * 64;
    bf16x8 qr[4];
#pragma unroll
    for (int d0 = 0; d0 < 4; ++d0) qr[d0] = *reinterpret_cast<const bf16x8*>(&Qw[r32 * 64 + d0 * 16 + hi * 8]);
    DA_DMA(0, 0, 0); DA_DMA(1, 1, 1);
    f32x16 negm = f32x16{};
    if constexpr (SHIFT) { const float nm = -TT.mb;
#pragma unroll
        for (int r = 0; r < 16; ++r) negm[r] = nm;
        asm volatile("" : "+v"(negm)); }
    f32x16 o[4]; o[0] = f32x16{}; o[1] = f32x16{}; o[2] = f32x16{}; o[3] = f32x16{};
    typedef float f32x2_t __attribute__((ext_vector_type(2)));
    f32x2_t lA = {0.f, 0.f}, lB = {0.f, 0.f};
    const int qrel = rg * 32 + r32;
    const int ksw = (r32 >> 1) & 7;
    const lds_cptr kp0 = shm3 + LDS_K + c * 8192 + r32 * 128;
    const int kof0 = ((0 + hi) ^ ksw) * 16, kof1 = ((2 + hi) ^ ksw) * 16, kof2 = ((4 + hi) ^ ksw) * 16, kof3 = ((6 + hi) ^ ksw) * 16;
    const int vq = (lane & 15) >> 2;
    const int vb0 = (int)(lds0 + LDS_V) + (4 * hi + vq) * 256 + ((lane >> 4) & 1) * 32 + (lane & 3) * 8;
    s16x4 vl[2][4], vh[2][4];
#define DA_VRD(db, vb_) do { _Pragma("unroll") for (int ks_ = 0; ks_ < 4; ++ks_) { \
            asm volatile("ds_read_b64_tr_b16 %0,%1 offset:%c2" : "=&v"(vl[(db) & 1][ks_]) : "v"(vb_ + (((db) ^ vq) * 64)), "i"(ks_ * 4096) : "memory"); \
            asm volatile("ds_read_b64_tr_b16 %0,%1 offset:%c2" : "=&v"(vh[(db) & 1][ks_]) : "v"(vb_ + (((db) ^ vq) * 64)), "i"(ks_ * 4096 + 2048) : "memory"); } } while (0)
#define DA_PVMM(db) do { __builtin_amdgcn_sched_barrier(0); _Pragma("unroll") for (int ks_ = 0; ks_ < 4; ++ks_) { \
            const bf16x8 vf_ = (bf16x8){vl[(db) & 1][ks_][0], vl[(db) & 1][ks_][1], vl[(db) & 1][ks_][2], vl[(db) & 1][ks_][3], vh[(db) & 1][ks_][0], vh[(db) & 1][ks_][1], vh[(db) & 1][ks_][2], vh[(db) & 1][ks_][3]}; \
            o[db] = __builtin_amdgcn_mfma_f32_32x32x16_bf16(__builtin_bit_cast(bf16x8, pw[ks_]), vf_, o[db], 0, 0, 0); } __builtin_amdgcn_sched_barrier(0); } while (0)
#define DA_PV_REST(vb_) do { asm volatile("s_waitcnt lgkmcnt(8)" ::: "memory"); DA_PVMM(0); DA_VRD(2, vb_); asm volatile("s_waitcnt lgkmcnt(8)" ::: "memory"); DA_PVMM(1); DA_VRD(3, vb_); \
        asm volatile("s_waitcnt lgkmcnt(8)" ::: "memory"); DA_PVMM(2); asm volatile("s_waitcnt lgkmcnt(0)" ::: "memory"); DA_PVMM(3); } while (0)
    u32x4 pw[4];
    int ksl = 0, vsl = 0;
#define DA_PVX1(db, ks_) do { const bf16x8 vf_ = (bf16x8){vl[(db) & 1][ks_][0], vl[(db) & 1][ks_][1], vl[(db) & 1][ks_][2], vl[(db) & 1][ks_][3], vh[(db) & 1][ks_][0], vh[(db) & 1][ks_][1], vh[(db) & 1][ks_][2], vh[(db) & 1][ks_][3]}; \
            o[db] = __builtin_amdgcn_mfma_f32_32x32x16_bf16(__builtin_bit_cast(bf16x8, pw[ks_]), vf_, o[db], 0, 0, 0); \
            p1[4 * (db) + ks_] = __builtin_amdgcn_exp2f(p1[4 * (db) + ks_]); asm volatile("" : "+v"(p0), "+v"(p1)); __builtin_amdgcn_sched_barrier(0); } while (0)
#define DA_PVX(db) do { __builtin_amdgcn_sched_barrier(0); DA_PVX1(db, 0); DA_PVX1(db, 1); DA_PVX1(db, 2); DA_PVX1(db, 3); } while (0)
    for (int t = 0; t < NT; ++t) {
        if (t + 1 < NT) { DA_WAIT_BAR(4); } else { DA_WAIT_BAR(0); }
        const lds_cptr kp = kp0 + ksl * KSLOT;
        bf16x8 kf[8];
#pragma unroll
        for (int d0 = 0; d0 < 4; ++d0) { const int ko = (d0 == 0) ? kof0 : (d0 == 1) ? kof1 : (d0 == 2) ? kof2 : kof3;
            kf[2 * d0] = *(const __attribute__((address_space(3))) bf16x8*)(kp + ko); kf[2 * d0 + 1] = *(const __attribute__((address_space(3))) bf16x8*)(kp + ko + 4096); }
        f32x16 p0, p1;
        p0 = __builtin_amdgcn_mfma_f32_32x32x16_bf16(kf[0], qr[0], negm, 0, 0, 0);
#pragma unroll
        for (int d0 = 1; d0 < 4; ++d0) p0 = __builtin_amdgcn_mfma_f32_32x32x16_bf16(kf[2 * d0], qr[d0], p0, 0, 0, 0);
#define DA_QX(d0_) do { p1 = __builtin_amdgcn_mfma_f32_32x32x16_bf16(kf[2 * (d0_) + 1], qr[d0_], (d0_) == 0 ? negm : p1, 0, 0, 0); \
            _Pragma("unroll") for (int r_ = 0; r_ < 4; ++r_) p0[4 * (d0_) + r_] = __builtin_amdgcn_exp2f(p0[4 * (d0_) + r_]); asm volatile("" : "+v"(p0)); __builtin_amdgcn_sched_barrier(0); } while (0)
        __builtin_amdgcn_sched_barrier(0); DA_QX(0); DA_QX(1); DA_QX(2); DA_QX(3);
#undef DA_QX
        if (t + 2 < NT) { DA_DMA(t + 2, (ksl >= 1) ? ksl - 1 : 2, (vsl + 2) & 3); }
        if (t >= NT - 2) {
            const int kb = 64 * (t - (NT - 2)) + 4 * hi;
#pragma unroll
            for (int r = 0; r < 16; ++r) { const int kv = kb + (r & 3) + 8 * (r >> 2); if (kv > qrel) p0[r] = 0.f; if (kv + 32 > qrel) p1[r] = -INFINITY; }
        }
        if (t > 0) {
            const int vb = vb0 + ((vsl + 3) & 3) * VSLOT;
            asm volatile("s_waitcnt lgkmcnt(8)" ::: "memory"); DA_PVX(0); DA_VRD(2, vb); asm volatile("s_waitcnt lgkmcnt(8)" ::: "memory"); DA_PVX(1); DA_VRD(3, vb);
            asm volatile("s_waitcnt lgkmcnt(8)" ::: "memory"); DA_PVX(2);
            { const int vbc = vb0 + vsl * VSLOT; DA_VRD(0, vbc); }
            asm volatile("s_waitcnt lgkmcnt(8)" ::: "memory"); DA_PVX(3);
        } else {
#pragma unroll
            for (int r = 0; r < 16; ++r) p1[r] = __builtin_amdgcn_exp2f(p1[r]);
        }
        { const int vbc = vb0 + vsl * VSLOT; if (t == 0) { asm volatile("s_waitcnt lgkmcnt(0)" ::: "memory"); DA_VRD(0, vbc); } DA_VRD(1, vbc); }
        __builtin_amdgcn_sched_barrier(0);
#pragma unroll
        for (int i = 0; i < 8; ++i) { lA += (f32x2_t){p0[2 * i], p0[2 * i + 1]}; lB += (f32x2_t){p1[2 * i], p1[2 * i + 1]}; }
#pragma unroll
        for (int e = 0; e < 4; ++e) { pw[0][e] = attn_body::cvtpk_s(p0[2 * e], p0[2 * e + 1]); pw[1][e] = attn_body::cvtpk_s(p0[8 + 2 * e], p0[9 + 2 * e]);
            pw[2][e] = attn_body::cvtpk_s(p1[2 * e], p1[2 * e + 1]); pw[3][e] = attn_body::cvtpk_s(p1[8 + 2 * e], p1[9 + 2 * e]); }
        ksl = (ksl == 2) ? 0 : ksl + 1; vsl = (vsl + 1) & 3;
    }
    { const int vb = vb0 + ((vsl + 3) & 3) * VSLOT; DA_PV_REST(vb); }
#undef DA_PVX1
#undef DA_PVX
#undef DA_VRD
#undef DA_PVMM
#undef DA_PV_REST
#undef DA_DMA
    float l_reg = (lA.x + lA.y) + (lB.x + lB.y);
    { auto rr = __builtin_amdgcn_permlane32_swap(__float_as_uint(l_reg), __float_as_uint(l_reg), false, false); l_reg = __uint_as_float(rr[0]) + __uint_as_float(rr[1]); }
    float* wsf = (float*)(shm + LDS_WS) + wid * 64;
    if (hi == 0) wsf[r32] = l_reg;
    asm volatile("s_waitcnt lgkmcnt(0)" ::: "memory");
    float rli[16];
    const float lsc = c ? TT.lam : 1.0f;
#pragma unroll
    for (int r = 0; r < 16; ++r) rli[r] = lsc * __builtin_amdgcn_rcpf(wsf[crow(r, hi)]);
#pragma unroll
    for (int db = 0; db < 4; ++db)
#pragma unroll
        for (int r = 0; r < 16; ++r) o[db][r] *= rli[r];
    DA_BAR();
    float* nat = (float*)shm + rg * 4096 + lane;
    if (c == 1) {
#pragma unroll
        for (int db = 0; db < 4; ++db)
#pragma unroll
            for (int r = 0; r < 16; ++r) nat[(db * 16 + r) * 64] = o[db][r];
    }
    DA_BAR();
    if (c == 0) {
#pragma unroll
        for (int db = 0; db < 4; ++db)
#pragma unroll
            for (int r = 0; r < 16; ++r) o[db][r] -= nat[(db * 16 + r) * 64];
    }
    DA_BAR();
    if (c == 0) {
        char* rt = shm + rg * EP_TILE + r32 * 4;
#pragma unroll
        for (int db = 0; db < 4; ++db)
#pragma unroll
            for (int r = 0; r < 16; ++r) *(float*)(rt + crow(r, hi) * EP_ROWB + db * 128) = o[db][r];
    }
    DA_BAR();
    {
        const int row = tid >> 2, qt = tid & 3;
        const char* rp = shm + (row >> 5) * EP_TILE + (row & 31) * EP_ROWB + qt * 128;
        typedef float f32x4_t __attribute__((ext_vector_type(4)));
        f32x4_t v[8]; float ss = 0.f;
#pragma unroll
        for (int i = 0; i < 8; ++i) { v[i] = *(const f32x4_t*)(rp + 16 * i); ss += (v[i][0] * v[i][0] + v[i][1] * v[i][1]) + (v[i][2] * v[i][2] + v[i][3] * v[i][3]); }
        ss += __shfl_xor(ss, 1); ss += __shfl_xor(ss, 2);
        const float rs = TT.post / sqrtf(ss * (1.0f / 128.0f) + 1e-6f);
        const f32x4_t* gp = (const f32x4_t*)(TT.subg + qt * 32);
        bf16* op = TT.ON + (long)(q0 + row) * PITCH + h * 128 + qt * 32;
#pragma unroll
        for (int i = 0; i < 4; ++i) { const f32x4_t a = v[2 * i] * gp[2 * i] * rs, b = v[2 * i + 1] * gp[2 * i + 1] * rs; u32x4 w;
            w[0] = attn_body::cvtpk_s(a[0], a[1]); w[1] = attn_body::cvtpk_s(a[2], a[3]); w[2] = attn_body::cvtpk_s(b[0], b[1]); w[3] = attn_body::cvtpk_s(b[2], b[3]);
            *(u32x4*)(op + 8 * i) = w; }
    }
    DA_BAR();
}
__device__ __forceinline__ void phase(char* lds, const Tensors& TT, int vcu) {
    const int x = vcu >> 5, j = vcu & 31;
    if (TT.mb > 64.0f) { for (int i = 0; i < 8; ++i) { const int h = 2 * x + (i >> 2), k = i & 3; const int qb = (k == 0) ? 127 - j : (k == 1) ? 64 + j : (k == 2) ? 63 - j : j; unit<true>(TT, h, qb, lds); } }
    else { for (int i = 0; i < 8; ++i) { const int h = 2 * x + (i >> 2), k = i & 3; const int qb = (k == 0) ? 127 - j : (k == 1) ? 64 + j : (k == 2) ? 63 - j : j; unit<false>(TT, h, qb, lds); } }
}
#undef DA_WAIT_BAR
#undef DA_BAR
}
constexpr int NWAVES = 8;
#ifndef EN_MASK
#define EN_MASK 0xffff
#endif
#define EN(k) ((EN_MASK >> (k)) & 1)
#ifndef REP_MASK
#define REP_MASK 0
#endif
#define REP(k) (1 + ((REP_MASK >> (k)) & 1))
#ifndef MK_SPLIT
#define MK_SPLIT 0
#endif
constexpr int T = 16384, D = 2048, FF = 5632, DEPTH = 4, M = T;
constexpr int N_PHASES = 2 * (10 + 11);
constexpr float NORM_EPS = 1e-6f;

constexpr size_t MiB = 1u << 20;
constexpr size_t WS_CTL = 0, CTL_ZERO_BYTES = 1 * MiB;
constexpr size_t WS_SMALL = 1 * MiB;
constexpr size_t WS_ROPE = 2 * MiB;
constexpr size_t WS_RTAB = 4 * MiB;
constexpr size_t WS_W1GU = 32 * MiB, WS_W1D = 76 * MiB, WS_W2GU = 98 * MiB, WS_W2D = 142 * MiB, WS_WMIX = 164 * MiB;
constexpr size_t WS_XN = 228 * MiB;
constexpr size_t WS_ACT = 292 * MiB;
constexpr size_t WS_H = WS_ACT;
constexpr size_t WS_Q = WS_ACT, WS_K = WS_ACT + 64 * MiB, WS_V = WS_ACT + 128 * MiB, WS_O0 = WS_ACT + 192 * MiB, WS_O1 = WS_ACT + 256 * MiB, WS_ON = WS_ACT + 320 * MiB;
constexpr size_t WS_QR = WS_ACT, WS_KR = WS_ACT + 64 * MiB, WS_KZT = WS_ACT + 128 * MiB, WS_VT = WS_ACT + 192 * MiB, WS_GS = WS_ACT + 320 * MiB, WS_RT = WS_ACT + 448 * MiB;
constexpr size_t WS_END = WS_ACT + 704 * MiB;
static_assert(WS_W1GU + (size_t)2 * FF * D * 2 <= WS_W1D && WS_W1D + (size_t)D * FF * 2 <= WS_W2GU && WS_W2GU + (size_t)2 * FF * D * 2 <= WS_W2D && WS_W2D + (size_t)D * FF * 2 <= WS_WMIX && WS_WMIX + 64 * MiB <= WS_XN, "weight map");
static_assert(WS_XN + (size_t)T * D * 2 <= WS_ACT && WS_H + (size_t)T * FF * 2 <= WS_END && WS_RT + (size_t)128 * 8 * 512 * 256 * 2 <= WS_END && WS_KZT + (size_t)2048 * T * 2 <= WS_VT && WS_VT + (size_t)4096 * T * 2 <= WS_GS && WS_GS + (size_t)T * 4096 * 2 <= WS_RT, "activation map");
constexpr int CW_TMO = 0, CW_CODE = 1;
constexpr int CW_BAR = 4096;

constexpr int RING_OFF = 0, RING_BYTES = 131072;
constexpr int LDSCTL_OFF = RING_BYTES, MISC_OFF = LDSCTL_OFF + 320, PTAB_OFF = LDSCTL_OFF + 1024;
constexpr int LDS_BYTES = 147456;
static_assert(MISC_OFF + 128 <= PTAB_OFF && PTAB_OFF + 28 * 8 <= LDS_BYTES, "LDS map");

#define GAS __attribute__((address_space(1)))
#define LAS __attribute__((address_space(3)))
typedef unsigned short bf16;
typedef unsigned v4u __attribute__((ext_vector_type(4)));
typedef float f32x4 __attribute__((ext_vector_type(4)));
typedef short bf16x8 __attribute__((ext_vector_type(8)));
typedef GAS unsigned gu32;
typedef GAS unsigned long long gu64;
#define RLX_AGENT __ATOMIC_RELAXED, __HIP_MEMORY_SCOPE_AGENT
#define LDS_WAIT() asm volatile("s_waitcnt lgkmcnt(0)" ::: "memory")
#define VM_WAIT() asm volatile("s_waitcnt vmcnt(0)" ::: "memory")
__device__ __forceinline__ unsigned long long rt() { return __builtin_amdgcn_s_memrealtime(); }
__device__ __forceinline__ unsigned f2bf(float f) { unsigned u = __builtin_bit_cast(unsigned, f); return (u + 0x7fffu + ((u >> 16) & 1u)) >> 16; }
__device__ __forceinline__ unsigned pk2(float lo, float hi) { unsigned r; asm("v_cvt_pk_bf16_f32 %0, %1, %2" : "=v"(r) : "v"(lo), "v"(hi)); return r; }

#define XB_TMO      128
#define XB_XCNT(j)  (256  + 64 * (j))
#define XB_XSUB(j)  (1280 + 64 * (j))
#define XB_XGEN(j)  (2304 + 64 * (j))
#define XB_TOP      3328
#define XB_TOPGEN   3392
#define XCD_BAR_WORDS 3456
#define XB_SPIN_CAP (1u << 18)

__device__ __forceinline__ unsigned xb_ld(unsigned* p)              { return __hip_atomic_load(p, __ATOMIC_RELAXED, __HIP_MEMORY_SCOPE_AGENT); }
__device__ __forceinline__ unsigned xb_add(unsigned* p, unsigned v) { return __hip_atomic_fetch_add(p, v, __ATOMIC_RELAXED, __HIP_MEMORY_SCOPE_AGENT); }
__device__ __forceinline__ unsigned xb_xcc_id() { return (unsigned)__builtin_amdgcn_s_getreg((3 << 11) | 20) & 0xFu; }
#define XB_SPIN(cond, bar) do { unsigned _sp = 0; while (cond) { __builtin_amdgcn_s_sleep(1); \
    if ((++_sp & 255u) == 0u) { if (xb_ld(&(bar)[XB_TMO])) break; if (_sp > XB_SPIN_CAP) { atomicAdd(&(bar)[XB_TMO], 1u); break; } } } } while (0)

struct XcdBarrier {
    unsigned* bar; unsigned x;
    volatile LAS unsigned* st;
};

__device__ __forceinline__ XcdBarrier xcd_barrier_post(unsigned* bar, volatile LAS unsigned* st) {
    XcdBarrier b; b.bar = bar; b.x = xb_xcc_id(); b.st = st;
    if (threadIdx.x == 0) (void)xb_add(&bar[XB_XCNT(b.x)], 1u);
    return b;
}
__device__ __forceinline__ void xcd_barrier_complete(unsigned* bar, unsigned x, unsigned& nloc, unsigned& nx) {
    const unsigned G = gridDim.x * gridDim.y * gridDim.z;
    unsigned sum, cnt, mine, sp = 0u;
    for (;;) {
        sum = 0u; cnt = 0u; mine = 0u;
#pragma unroll
        for (unsigned j = 0; j < 16; ++j) { const unsigned c = xb_ld(&bar[XB_XCNT(j)]); sum += c; cnt += (c > 0u) ? 1u : 0u; mine = (j == x) ? c : mine; }
        if (sum == G) break;
        __builtin_amdgcn_s_sleep(1);
        if ((++sp & 255u) == 0u) { if (xb_ld(&bar[XB_TMO])) break; if (sp > XB_SPIN_CAP) { atomicAdd(&bar[XB_TMO], 1u); break; } }
    }
    nloc = mine > 0u ? mine : 1u; nx = cnt > 0u ? cnt : 1u;
}

__device__ __forceinline__ void xcd_barrier(const XcdBarrier& b) {
    asm volatile("s_waitcnt vmcnt(0)" ::: "memory");
    __syncthreads();
    if (threadIdx.x == 0) {
        unsigned* bar = b.bar;
        __builtin_amdgcn_s_waitcnt(0);
        unsigned nloc = b.st[0], nx = b.st[1];
        if (nloc == 0u) { xcd_barrier_complete(bar, b.x, nloc, nx); b.st[0] = nloc; b.st[1] = nx; }
        const unsigned old = xb_add(&bar[XB_XSUB(b.x)], 1u);
        const unsigned gen = old / nloc;
        if (old + 1u == (gen + 1u) * nloc) {
            __builtin_amdgcn_fence(__ATOMIC_RELEASE, "agent");
            asm volatile("s_waitcnt vmcnt(0)" ::: "memory");
            const unsigned og = xb_add(&bar[XB_TOP], 1u);
            const unsigned tg = og / nx;
            if (og + 1u == (tg + 1u) * nx) xb_add(&bar[XB_TOPGEN], 1u);
            else XB_SPIN(xb_ld(&bar[XB_TOPGEN]) == tg, bar);
            __builtin_amdgcn_fence(__ATOMIC_ACQUIRE, "agent");
            xb_add(&bar[XB_XGEN(b.x)], 1u);
            asm volatile("s_waitcnt vmcnt(0)" ::: "memory");
        } else {
            XB_SPIN(xb_ld(&bar[XB_XGEN(b.x)]) == gen, bar);
            __builtin_amdgcn_fence(__ATOMIC_ACQUIRE, "agent");
            asm volatile("s_waitcnt vmcnt(0)" ::: "memory");
        }
    }
    __syncthreads();
}

typedef float f32x2 __attribute__((ext_vector_type(2)));

struct Frame {
    LAS unsigned char* lds;
    volatile LAS unsigned* MISC;
    gu32* ctl;
    int tid, lane, wave;
    int vcu, G;
    unsigned char* ws;
};

__device__ __forceinline__ float wave_sum(float v) {
#define WS_DPP(ctrl, rmask) v += __int_as_float(__builtin_amdgcn_update_dpp(0, __float_as_int(v), ctrl, rmask, 0xF, false))
    WS_DPP(0xB1, 0xF);
    WS_DPP(0x4E, 0xF);
    WS_DPP(0x141, 0xF);
    WS_DPP(0x140, 0xF);
    WS_DPP(0x142, 0xA);
    WS_DPP(0x143, 0xC);
#undef WS_DPP
    return __int_as_float(__builtin_amdgcn_readlane(__float_as_int(v), 63));
}
__device__ __forceinline__ int conv_drow(int mode, int row_off, int n0) {
    if (mode == 0) return row_off + n0;
    if (mode == 1) return 256 * (n0 >> 7) + (n0 & 127);
    if (mode == 2) return 256 * (n0 >> 7) + 128 + (n0 & 127);
    const int cl = n0 & 255; return row_off + (n0 & ~255) + 128 * ((cl & 63) >> 5) + 32 * (cl >> 6);
}
struct ConvPend { f32x4 wv[8]; bf16* WT; int K, drow0, k0, valid; };
__device__ __forceinline__ void conv_finish(ConvPend& P, LAS float* scr, int lane) {
    LAS float* sp = scr + (lane >> 3) * 33 + 4 * (lane & 7);
#pragma unroll
    for (int i = 0; i < 8; ++i) { sp[(8 * i) * 33 + 0] = P.wv[i].x; sp[(8 * i) * 33 + 1] = P.wv[i].y; sp[(8 * i) * 33 + 2] = P.wv[i].z; sp[(8 * i) * 33 + 3] = P.wv[i].w; }
    LDS_WAIT(); asm volatile("" ::: "memory");
    const int c = lane & 7;
#pragma unroll
    for (int j = 0; j < 4; ++j) { const int n = (lane >> 3) + 8 * j; const LAS float* s = scr + (8 * c) * 33 + n;
        v4u o; o.x = pk2(s[0 * 33], s[1 * 33]); o.y = pk2(s[2 * 33], s[3 * 33]); o.z = pk2(s[4 * 33], s[5 * 33]); o.w = pk2(s[6 * 33], s[7 * 33]);
        *(GAS v4u*)(P.WT + (size_t)(P.drow0 + n) * P.K + P.k0 + 8 * c) = o; }
    LDS_WAIT(); asm volatile("" ::: "memory");
}
__device__ __forceinline__ int conv_matrix(Frame& F, const float* W, int K, int N, bf16* WT, int mode, int row_off, int prefix, ConvPend& P) {
    LAS float* scr = (LAS float*)(F.lds + RING_OFF + F.wave * 16384);
    const int NGW = F.G * NWAVES, gw = F.vcu * NWAVES + F.wave, nitems = (K / 64) * (N / 32), nblk = N / 32;
    int start = (gw - prefix % NGW + NGW) % NGW;
    for (int it = start; it < nitems; it += NGW) {
        const int kb = it / nblk, nb = it % nblk, k0 = 64 * kb, n0 = 32 * nb;
        f32x4 nw[8]; const float* wp = W + (size_t)(k0 + (F.lane >> 3)) * N + n0 + 4 * (F.lane & 7);
#pragma unroll
        for (int i = 0; i < 8; ++i) nw[i] = __builtin_nontemporal_load((const GAS f32x4*)(wp + (size_t)(8 * i) * N));
        if (P.valid) conv_finish(P, scr, F.lane);
#pragma unroll
        for (int i = 0; i < 8; ++i) P.wv[i] = nw[i];
        P.WT = WT; P.K = K; P.drow0 = conv_drow(mode, row_off, n0); P.k0 = k0; P.valid = 1;
    }
    return prefix + nitems;
}
__device__ __forceinline__ void rmsnorm_phase(Frame& F, const float* x, const float* g, bf16* xn) {
    const int NGW = F.G * NWAVES, gw = F.vcu * NWAVES + F.wave;
    f32x4 gv[8];
#pragma unroll
    for (int j = 0; j < 8; ++j) gv[j] = ((const GAS f32x4*)g)[64 * j + F.lane];
    f32x4 vn[8];
    if (gw < T) { const GAS f32x4* xr0 = (const GAS f32x4*)(x + (size_t)gw * D) + F.lane;
#pragma unroll
        for (int j = 0; j < 8; ++j) vn[j] = xr0[64 * j]; }
    for (int m = gw; m < T; m += NGW) {
        f32x4 v[8]; float s = 0.f;
#pragma unroll
        for (int j = 0; j < 8; ++j) { v[j] = vn[j]; s += (v[j].x * v[j].x + v[j].y * v[j].y) + (v[j].z * v[j].z + v[j].w * v[j].w); }
        if (m + NGW < T) { const GAS f32x4* xr1 = (const GAS f32x4*)(x + (size_t)(m + NGW) * D) + F.lane;
#pragma unroll
            for (int j = 0; j < 8; ++j) vn[j] = xr1[64 * j]; }
        const float rs = 1.0f / sqrtf(wave_sum(s) * (1.0f / D) + NORM_EPS);
        GAS unsigned long long* o8 = (GAS unsigned long long*)(xn + (size_t)m * D) + F.lane;
#pragma unroll
        for (int j = 0; j < 8; ++j) { const f32x4 y = v[j] * rs * gv[j]; o8[64 * j] = (unsigned long long)pk2(y.x, y.y) | ((unsigned long long)pk2(y.z, y.w) << 32); }
    }
}
__device__ __forceinline__ void sincos_d(double a, float& sn, float& cs) {
    const double k = __builtin_rint(a * 0.63661977236758134308);
    double r = __builtin_fma(-k, 1.57079632679489655800e+00, a); r = __builtin_fma(-k, 6.12323399573676603587e-17, r);
    const double r2 = r * r;
    double sp = -1.6059043836821613e-10; sp = sp * r2 + 2.5052108385441720e-08; sp = sp * r2 - 2.7557319223985893e-06; sp = sp * r2 + 1.9841269841269841e-04;
    sp = sp * r2 - 8.3333333333333332e-03; sp = sp * r2 + 1.6666666666666666e-01; const double s = r - r * r2 * sp;
    double cp = 2.0876756987868099e-09; cp = cp * r2 - 2.7557319223985888e-07; cp = cp * r2 + 2.4801587301587302e-05; cp = cp * r2 - 1.3888888888888889e-03;
    cp = cp * r2 + 4.1666666666666664e-02; const double c = 1.0 - 0.5 * r2 + r2 * r2 * cp;
    const int q = (int)((long long)k & 3);
    const double so = (q == 0) ? s : (q == 1) ? c : (q == 2) ? -s : -c, co = (q == 0) ? c : (q == 1) ? -s : (q == 2) ? -c : s;
    sn = (float)so; cs = (float)co;
}
__device__ __forceinline__ double rope_freq(int i) {
    return i == 0 ? 1.0 : i == 1 ? 0.19392274474868576 : i == 2 ? 0.037606030930863933 : i == 3 ? 0.0072926647372171093 : i == 4 ? 0.001414213562373095 :
           i == 5 ? 0.0002742481756762073 : i == 6 ? 5.3182958969449883e-05 : 1.031338537721246e-05;
}
__device__ __forceinline__ void tables_phase(Frame& F, const float* lq1, const float* lk1, const float* lq2, const float* lk2, const float* qg, const float* kg) {
    const int NT = F.G * NWAVES * 64, gt = (F.vcu * NWAVES + F.wave) * 64 + F.lane;
    float* rope = (float*)(F.ws + WS_ROPE); float* rtab = (float*)(F.ws + WS_RTAB);
    for (int e = gt; e < T * 8; e += NT) { const int pos = e >> 3, i = e & 7; float sn, cs; sincos_d((double)pos * rope_freq(i), sn, cs); *(GAS f32x2*)(rope + (size_t)e * 2) = (f32x2){cs, sn}; }
    for (int e = gt; e < T * 128; e += NT) { const int pos = e >> 7, j = e & 127;
        const double ang = exp2(-(double)j * (13.287712379549449 / 127.0));
        float sn, cs; sincos_d((double)pos * ang, sn, cs); *(GAS f32x2*)(rtab + (size_t)e * 2) = (f32x2){cs, sn}; }
    if (blockIdx.x == 0 && F.wave < 2) {
        const int l = F.wave; const float q1 = lq1[l * 64 + F.lane], k1 = lk1[l * 64 + F.lane], q2 = lq2[l * 64 + F.lane], k2 = lk2[l * 64 + F.lane];
        const float d1 = wave_sum(q1 * k1), d2 = wave_sum(q2 * k2); const float linit = (l == 0) ? 0.2f : 0.4707130183435842f;
        if (F.lane == 0) ((float*)(F.ws + WS_SMALL))[l] = expf(d1) - expf(d2) + linit;
    }
    if (blockIdx.x == 0 && F.wave >= 2 && F.wave < 4) {
        const int l = F.wave - 2; float a = fabsf(qg[l * 64 + F.lane]), b = fabsf(kg[l * 64 + F.lane]);
#pragma unroll
        for (int o = 1; o < 64; o <<= 1) { a = fmaxf(a, __shfl_xor(a, o)); b = fmaxf(b, __shfl_xor(b, o)); }
        if (F.lane == 0) ((float*)(F.ws + WS_SMALL))[2 + l] = 8.0f * a * b * 1.4426950408889634f * 1.01f;
    }
}
__device__ __forceinline__ void combine_phase(Frame& F, const bf16* O0, const bf16* O1, const float* subg, float lam, float post, bf16* ON) {
    const int NGW = F.G * NWAVES, gw = F.vcu * NWAVES + F.wave;
    f32x4 g0[4], g1[4];
#pragma unroll
    for (int i = 0; i < 4; ++i) { g0[i] = *(const GAS f32x4*)(subg + (F.lane & 15) * 8) * post; g1[i] = *(const GAS f32x4*)(subg + (F.lane & 15) * 8 + 4) * post; }
    for (int m = gw; m < T; m += NGW) {
        const GAS v4u* p0 = (const GAS v4u*)(O0 + (size_t)m * D) + F.lane; const GAS v4u* p1 = (const GAS v4u*)(O1 + (size_t)m * D) + F.lane;
        GAS v4u* po = (GAS v4u*)(ON + (size_t)m * D) + F.lane;
#pragma unroll
        for (int i = 0; i < 4; ++i) {
            const v4u a = p0[64 * i], b = p1[64 * i]; float o[8]; float ss = 0.f;
#pragma unroll
            for (int e = 0; e < 4; ++e) { const unsigned ua = a[e], ub = b[e];
                o[2 * e] = __uint_as_float(ua << 16) - lam * __uint_as_float(ub << 16); o[2 * e + 1] = __uint_as_float(ua & 0xffff0000u) - lam * __uint_as_float(ub & 0xffff0000u);
                ss += o[2 * e] * o[2 * e] + o[2 * e + 1] * o[2 * e + 1]; }
            ss += __shfl_xor(ss, 1); ss += __shfl_xor(ss, 2); ss += __shfl_xor(ss, 4); ss += __shfl_xor(ss, 8);
            const float rs = 1.0f / sqrtf(ss * (1.0f / 128.0f) + NORM_EPS);
            v4u w; w.x = pk2(o[0] * rs * g0[i][0], o[1] * rs * g0[i][1]); w.y = pk2(o[2] * rs * g0[i][2], o[3] * rs * g0[i][3]);
            w.z = pk2(o[4] * rs * g1[i][0], o[5] * rs * g1[i][1]); w.w = pk2(o[6] * rs * g1[i][2], o[7] * rs * g1[i][3]);
            po[64 * i] = w;
        }
    }
}
__device__ __forceinline__ float ret_log2gamma(int h) { return pg8::EpiRetProj::log2gamma(h); }
__device__ __forceinline__ void ret_scan_phase(Frame& F, const bf16* KZT, const bf16* VT, bf16* RT) {
    const int g = F.lane >> 4, fr = F.lane & 15, w = F.wave;
    LAS unsigned char* const ring = F.lds + RING_OFF;
    for (int s = F.vcu; s < 256; s += F.G) {
        const int h = s >> 5, dvb = (s >> 2) & 7, dkb = s & 3, dv0 = 64 * dvb + 16 * (w >> 1), dk0 = 64 * dkb + 32 * (w & 1);
        const float dec = __builtin_amdgcn_exp2f(128.0f * ret_log2gamma(h));
        const bf16* src = ((w < 4) ? KZT + (size_t)(((256 * h + 64 * dkb) >> 4) + w) * (512 * 512) : VT + (size_t)(((512 * h + 64 * dvb) >> 4) + (w - 4)) * (512 * 512)) + F.lane * 8;
        bf16* rt = RT + (((size_t)h * 32 + (dv0 >> 4)) * 8 + (dk0 >> 5)) * 512 + (fr + 16 * (g >> 1)) * 8 + 4 * (g & 1);
        f32x4 acc[2] = {(f32x4){0.f, 0.f, 0.f, 0.f}, (f32x4){0.f, 0.f, 0.f, 0.f}};
#define RS_DMA(c) do { _Pragma("unroll") for (int ks = 0; ks < 4; ++ks) __builtin_amdgcn_global_load_lds((const unsigned*)(src + (size_t)(4 * (c) + ks) * 512), (LAS unsigned*)(ring + ((c) & 3) * 32768 + (4 * w + ks) * 1024), 16, 0, 0); } while (0)
        RS_DMA(0); RS_DMA(1); RS_DMA(2);
        const LAS unsigned char* afr = ring + (4 * (2 * (w & 1))) * 1024 + F.lane * 16;
        const LAS unsigned char* bfr = ring + (16 + 4 * (w >> 1)) * 1024 + F.lane * 16;
        for (int c = 0; c < 128; ++c) {
            if (c < 3) asm volatile("s_waitcnt vmcnt(8) lgkmcnt(0)\n\ts_barrier" ::: "memory"); else if (c < 126) asm volatile("s_waitcnt vmcnt(12) lgkmcnt(0)\n\ts_barrier" ::: "memory"); else asm volatile("s_waitcnt vmcnt(0) lgkmcnt(0)\n\ts_barrier" ::: "memory");
            if (c + 3 < 128) RS_DMA(c + 3);
            asm volatile("" ::: "memory");
            bf16* rc = rt + (size_t)c * (8 * 512 * 256);
#pragma unroll
            for (int t = 0; t < 2; ++t) { pg8::u32x2 wv; wv.x = pk2(acc[t][0], acc[t][1]); wv.y = pk2(acc[t][2], acc[t][3]); *(GAS pg8::u32x2*)(rc + 256 * t) = wv; }
            if (c == 127) break;
            const int so = (c & 3) * 32768;
            bf16x8 b[4];
#pragma unroll
            for (int ks = 0; ks < 4; ++ks) b[ks] = *(const LAS bf16x8*)(bfr + so + ks * 1024);
#pragma unroll
            for (int t = 0; t < 2; ++t) { acc[t] = acc[t] * dec;
#pragma unroll
                for (int ks = 0; ks < 4; ++ks) acc[t] = __builtin_amdgcn_mfma_f32_16x16x32_bf16(*(const LAS bf16x8*)(afr + so + t * 4096 + ks * 1024), b[ks], acc[t], 0, 0, 0); }
        }
        asm volatile("s_waitcnt vmcnt(0)" ::: "memory"); __syncthreads();
#undef RS_DMA
    }
}
__device__ __forceinline__ void ret_chunk_phase(Frame& F, const bf16* QR, const bf16* KR, const bf16* VT, const bf16* GS, const bf16* RT, bf16* YN) {
    const int g = F.lane >> 4, fr = F.lane & 15, w = F.wave;
    LAS unsigned char* const bufs = F.lds + RING_OFF;
    for (int unit = F.vcu; unit < 1024; unit += F.G) {
        const int h = unit & 7, c = 127 - (unit >> 3);
        const float l2g = ret_log2gamma(h);
        const int nrow = 16 * w + fr;
        const size_t row = (size_t)128 * c + nrow;
        const char* RTu = (const char*)(RT + ((size_t)c * 8 + h) * 512 * 256) + F.lane * 16;
        const char* VTu = (const char*)(VT + ((size_t)(32 * h) * 512 + 4 * c) * 512) + F.lane * 16;
        const char* RTw = RTu + (size_t)(w >> 1) * 8192;
        const char* VTw = VTu + (size_t)(w >> 1) * (512 * 1024);
        LAS unsigned char* const dstw = bufs + ((w >> 1) * 12 + 6 * (w & 1)) * 1024;
#define R2_DMA(st, bi) do { if (w & 1) { _Pragma("unroll") for (int j = 0; j < 6; ++j) { \
                const char* src_ = (j < 2) ? RTw + (size_t)(st) * 32768 + (6 + j) * 1024 : VTw + (size_t)(st) * ((size_t)4 * 512 * 1024) + (j - 2) * 1024; \
                __builtin_amdgcn_global_load_lds((const unsigned*)src_, (LAS unsigned*)(dstw + (bi) * 49152 + j * 1024), 16, 0, 2); } } \
            else { _Pragma("unroll") for (int j = 0; j < 6; ++j) __builtin_amdgcn_global_load_lds((const unsigned*)(RTw + (size_t)(st) * 32768 + j * 1024), (LAS unsigned*)(dstw + (bi) * 49152 + j * 1024), 16, 0, 2); } } while (0)
#define R2_SYNC() do { asm volatile("s_waitcnt vmcnt(0)" ::: "memory"); __syncthreads(); } while (0)
        LAS unsigned char* const karea = bufs + 49152;
        { const bf16* ksrc = KR + ((((size_t)(8 * c + w)) * 8 + h) * 8) * 512 + F.lane * 8;
#pragma unroll
            for (int ks = 0; ks < 8; ++ks) __builtin_amdgcn_global_load_lds((const unsigned*)(ksrc + 512 * ks), (LAS unsigned*)(karea + (w * 8 + ks) * 1024), 16, 0, 0); }
        R2_DMA(0, 0);
        bf16x8 qf[8];
#pragma unroll
        for (int ks = 0; ks < 8; ++ks) qf[ks] = *(const GAS bf16x8*)(QR + ((((size_t)(8 * c + w)) * 8 + h) * 8 + ks) * 512 + F.lane * 8);
        R2_SYNC();
        pg8::u32x2 pk[8];
#pragma unroll
        for (int mt = 0; mt < 8; ++mt) {
            if (mt <= w) {
                f32x4 s = (f32x4){0.f, 0.f, 0.f, 0.f};
#pragma unroll
                for (int ks = 0; ks < 8; ++ks) s = __builtin_amdgcn_mfma_f32_16x16x32_bf16(*(const LAS bf16x8*)(karea + (mt * 8 + ks) * 1024 + F.lane * 16), qf[ks], s, 0, 0, 0);
                float pv[4];
#pragma unroll
                for (int r = 0; r < 4; ++r) { const int d = nrow - (16 * mt + 4 * g + r); pv[r] = d >= 0 ? s[r] * __builtin_amdgcn_exp2f(l2g * (float)d) : 0.f; }
                pk[mt].x = pk2(pv[0], pv[1]); pk[mt].y = pk2(pv[2], pv[3]);
            } else { pk[mt].x = 0u; pk[mt].y = 0u; }
        }
        const float xi = __builtin_amdgcn_exp2f(l2g * (float)(nrow + 1));
        R2_SYNC();
        f32x4 Y[32];
#pragma unroll
        for (int st = 0; st < 8; ++st) {
            if (st + 1 < 8) R2_DMA(st + 1, (st + 1) & 1);
            const LAS unsigned char* bb = bufs + (st & 1) * 49152 + F.lane * 16;
#pragma unroll
            for (int dl = 0; dl < 4; ++dl) {
                f32x4 y = (f32x4){0.f, 0.f, 0.f, 0.f};
#pragma unroll
                for (int ks = 0; ks < 8; ++ks) y = __builtin_amdgcn_mfma_f32_16x16x32_bf16(*(const LAS bf16x8*)(bb + (dl * 12 + ks) * 1024), qf[ks], y, 0, 0, 0);
                y = y * xi;
#pragma unroll
                for (int k2 = 0; k2 < 4; ++k2) {
                    if (2 * k2 <= w) { const v4u bv = {pk[2 * k2].x, pk[2 * k2].y, pk[2 * k2 + 1].x, pk[2 * k2 + 1].y};
                        y = __builtin_amdgcn_mfma_f32_16x16x32_bf16(*(const LAS bf16x8*)(bb + (dl * 12 + 8 + k2) * 1024), __builtin_bit_cast(bf16x8, bv), y, 0, 0, 0); }
                }
                Y[4 * st + dl] = y;
            }
            R2_SYNC();
        }
#undef R2_DMA
#undef R2_SYNC
        float sum = 0.f;
#pragma unroll
        for (int dvt = 0; dvt < 32; ++dvt) sum += (Y[dvt][0] + Y[dvt][1]) + (Y[dvt][2] + Y[dvt][3]);
        sum += __shfl_xor(sum, 16); sum += __shfl_xor(sum, 32);
        const float mean = sum * (1.0f / 512.0f); float var = 0.f;
#pragma unroll
        for (int dvt = 0; dvt < 32; ++dvt) { const f32x4 dlt = Y[dvt] - mean; var += (dlt[0] * dlt[0] + dlt[1] * dlt[1]) + (dlt[2] * dlt[2] + dlt[3] * dlt[3]); }
        var += __shfl_xor(var, 16); var += __shfl_xor(var, 32);
        const float rstd = 1.0f / sqrtf(var * (1.0f / 512.0f) + NORM_EPS);
        const bf16* gp = GS + row * 4096 + 512 * h + 4 * g; bf16* op = YN + row * 4096 + 512 * h + 4 * g;
#pragma unroll
        for (int hb = 0; hb < 2; ++hb) {
            pg8::u32x2 gvv[16];
#pragma unroll
            for (int d = 0; d < 16; ++d) gvv[d] = *(const GAS pg8::u32x2*)(gp + 16 * (16 * hb + d));
#pragma unroll
            for (int d = 0; d < 16; ++d) { const int dvt = 16 * hb + d; const pg8::u32x2 gv = gvv[d];
                const float g0 = __uint_as_float(gv.x << 16), g1 = __uint_as_float(gv.x & 0xffff0000u), g2 = __uint_as_float(gv.y << 16), g3 = __uint_as_float(gv.y & 0xffff0000u);
                const f32x4 yh = (Y[dvt] - mean) * rstd;
                pg8::u32x2 o; o.x = pk2(yh[0] * g0, yh[1] * g1); o.y = pk2(yh[2] * g2, yh[3] * g3);
                *(GAS pg8::u32x2*)(op + 16 * dvt) = o; }
        }
    }
}

struct Args { const float* in[26]; float* out; unsigned char* ws; int ph_lo, ph_hi; };
#define INP(k) (args.in[k])
#define XOUT (args.out)
#define PH_ON (lo <= ph && ph < hi)
#define PH_END do { if (lo <= ph && ph + 1 < hi) { xcd_barrier(bar); if (REP(13) > 1) { xcd_barrier(bar); xcd_barrier(bar); xcd_barrier(bar); } } ++ph; } while (0)
#define FFN_GEMMS(WGU, WD, XIN) do { \
        if (PH_ON && EN(2)) { pg8::Gemm gg{((bf16*)(F.ws + WS_XN)), (const bf16*)(F.ws + (WGU)), M, 2 * FF, D}; pg8::StaticOrder S; S.init(M, 2 * FF, F.G, (int)blockIdx.x); \
            pg8::EpiSwiGLU E{(bf16*)(F.ws + WS_H), FF}; pg8::gemm_phase<pg8::EpiSwiGLU, pg8::StaticOrder, PG8_ALIGN, PG8_SP2>(F.lds + RING_OFF, gg, S, E); \
            if (REP(2) > 1) pg8::gemm_phase<pg8::EpiSwiGLU, pg8::StaticOrder, PG8_ALIGN, PG8_SP2>(F.lds + RING_OFF, gg, S, E); } \
        PH_END; \
        if (PH_ON && EN(3)) { pg8::Gemm gg{(const bf16*)(F.ws + WS_H), (const bf16*)(F.ws + (WD)), M, D, FF}; pg8::StaticOrder S; S.init(M, D, F.G, (int)blockIdx.x); \
            pg8::EpiResid E{(XIN), XOUT, D, 0.5f}; \
            if (REP(3) > 1) { pg8::EpiResid E2{(XIN), (float*)(F.ws + WS_END + 4 * MiB), D, 0.5f}; pg8::gemm_phase<pg8::EpiResid, pg8::StaticOrder, PG8_ALIGN, PG8_SP2>(F.lds + RING_OFF, gg, S, E2); } \
            pg8::gemm_phase<pg8::EpiResid, pg8::StaticOrder, PG8_ALIGN, PG8_SP2>(F.lds + RING_OFF, gg, S, E); } \
        PH_END; } while (0)
#define CONV_FFN(i) do { \
        pfx = conv_matrix(F, INP(2) + (size_t)(i) * D * FF, D, FF, (bf16*)(F.ws + WS_W1GU), 1, 0, pfx, CP); pfx = conv_matrix(F, INP(3) + (size_t)(i) * D * FF, D, FF, (bf16*)(F.ws + WS_W1GU), 2, 0, pfx, CP); \
        pfx = conv_matrix(F, INP(4) + (size_t)(i) * FF * D, FF, D, (bf16*)(F.ws + WS_W1D), 0, 0, pfx, CP); \
        pfx = conv_matrix(F, INP(23) + (size_t)(i) * D * FF, D, FF, (bf16*)(F.ws + WS_W2GU), 1, 0, pfx, CP); pfx = conv_matrix(F, INP(24) + (size_t)(i) * D * FF, D, FF, (bf16*)(F.ws + WS_W2GU), 2, 0, pfx, CP); \
        pfx = conv_matrix(F, INP(25) + (size_t)(i) * FF * D, FF, D, (bf16*)(F.ws + WS_W2D), 0, 0, pfx, CP); } while (0)

template <int lp> __device__ __forceinline__ void layer_pair(const Args& args, Frame& F, unsigned char* lds, const XcdBarrier& bar, const int lo, const int hi, int& ph) {
        {
            const int li = 2 * lp;
            const float* xin = (lp == 0) ? INP(0) : XOUT;
            if (PH_ON) {
                if (EN(0)) { if (lp == 0) { tables_phase(F, INP(12), INP(13), INP(14), INP(15), INP(10), INP(11)); if (REP(12) > 1) tables_phase(F, INP(12), INP(13), INP(14), INP(15), INP(10), INP(11)); }
                int pfx = 0; ConvPend CP; CP.valid = 0; CONV_FFN(li); if (REP(0) > 1) CONV_FFN(li);
                pfx = conv_matrix(F, INP(6) + (size_t)lp * D * D, D, 2048, (bf16*)(F.ws + WS_WMIX), 3, 0, pfx, CP); pfx = conv_matrix(F, INP(7) + (size_t)lp * D * D, D, 2048, (bf16*)(F.ws + WS_WMIX), 3, 2048, pfx, CP);
                pfx = conv_matrix(F, INP(8) + (size_t)lp * D * D, D, 2048, (bf16*)(F.ws + WS_WMIX), 3, 4096, pfx, CP); pfx = conv_matrix(F, INP(9) + (size_t)lp * D * D, 2048, D, (bf16*)(F.ws + WS_WMIX + 24 * MiB), 0, 0, pfx, CP);
                if (CP.valid) conv_finish(CP, (LAS float*)(F.lds + RING_OFF + F.wave * 16384), F.lane); }
                if (EN(1)) rmsnorm_phase(F, xin, INP(1) + (size_t)li * D, ((bf16*)(F.ws + WS_XN)));
            }
            PH_END;
            FFN_GEMMS(WS_W1GU, WS_W1D, xin);
            if (PH_ON && EN(1)) { if (REP(1) > 1) rmsnorm_phase(F, XOUT, INP(5) + (size_t)li * D, ((bf16*)(F.ws + WS_XN))); rmsnorm_phase(F, XOUT, INP(5) + (size_t)li * D, ((bf16*)(F.ws + WS_XN))); }
            PH_END;
            if (PH_ON && EN(4)) {
                pg8::Gemm gg{((bf16*)(F.ws + WS_XN)), (const bf16*)(F.ws + WS_WMIX), M, 6144, D}; pg8::StaticOrder S; S.init(M, 6144, F.G, (int)blockIdx.x);
                pg8::EpiQKVDiff E{(bf16*)(F.ws + WS_Q), (bf16*)(F.ws + WS_K), (bf16*)(F.ws + WS_V), INP(10) + lp * 64, INP(11) + lp * 64, (const float*)(F.ws + WS_ROPE), attn_body::C2, M};
                pg8::gemm_phase<pg8::EpiQKVDiff, pg8::StaticOrder, PG8_ALIGN, PG8_SP2>(F.lds + RING_OFF, gg, S, E);
                if (REP(4) > 1) pg8::gemm_phase<pg8::EpiQKVDiff, pg8::StaticOrder, PG8_ALIGN, PG8_SP2>(F.lds + RING_OFF, gg, S, E);
            }
            PH_END;
            if (PH_ON && EN(5)) {
                static_assert(da::LDS_END <= RING_BYTES && da::PITCH == D, "attention body geometry vs frame");
                const float linit = (lp == 0) ? 0.2f : 0.4707130183435842f;
                const da::Tensors AT{(const attn_body::bf16*)(F.ws + WS_Q), (const attn_body::bf16*)(F.ws + WS_K), (const attn_body::bf16*)(F.ws + WS_V), (attn_body::bf16*)(F.ws + WS_ON),
                                     INP(16) + lp * 128, __int_as_float(__builtin_amdgcn_readfirstlane(__float_as_int(((const float*)(F.ws + WS_SMALL))[lp]))), 1.0f - linit,
                                     __int_as_float(__builtin_amdgcn_readfirstlane(__float_as_int(((const float*)(F.ws + WS_SMALL))[2 + lp])))};
                da::phase((char*)lds + RING_OFF, AT, F.vcu);
                if (REP(5) > 1) da::phase((char*)lds + RING_OFF, AT, F.vcu);
            }
            PH_END;
            if (PH_ON && EN(7)) { pg8::Gemm gg{(const bf16*)(F.ws + WS_ON), (const bf16*)(F.ws + WS_WMIX + 24 * MiB), M, D, 2048}; pg8::StaticOrder S; S.init(M, D, F.G, (int)blockIdx.x);
                pg8::EpiResid E{XOUT, XOUT, D, 1.0f};
                if (REP(7) > 1) { pg8::EpiResid E2{XOUT, (float*)(F.ws + WS_END + 4 * MiB), D, 1.0f}; pg8::gemm_phase<pg8::EpiResid, pg8::StaticOrder, PG8_ALIGN, PG8_SP2>(F.lds + RING_OFF, gg, S, E2); }
                pg8::gemm_phase<pg8::EpiResid, pg8::StaticOrder, PG8_ALIGN, PG8_SP2>(F.lds + RING_OFF, gg, S, E); }
            PH_END;
            if (PH_ON && EN(1)) { if (REP(1) > 1) rmsnorm_phase(F, XOUT, INP(22) + (size_t)li * D, ((bf16*)(F.ws + WS_XN))); rmsnorm_phase(F, XOUT, INP(22) + (size_t)li * D, ((bf16*)(F.ws + WS_XN))); }
            PH_END;
            FFN_GEMMS(WS_W2GU, WS_W2D, XOUT);
        }
        {
            const int li = 2 * lp + 1;
            if (PH_ON) {
                if (EN(0)) { int pfx = 0; ConvPend CP; CP.valid = 0; CONV_FFN(li); if (REP(0) > 1) CONV_FFN(li);
                bf16* WP = (bf16*)(F.ws + WS_WMIX);
                pfx = conv_matrix(F, INP(17) + (size_t)lp * D * 2048, D, 2048, WP, 0, 0, pfx, CP); pfx = conv_matrix(F, INP(18) + (size_t)lp * D * 2048, D, 2048, WP, 0, 2048, pfx, CP);
                pfx = conv_matrix(F, INP(19) + (size_t)lp * D * 4096, D, 4096, WP, 0, 4096, pfx, CP); pfx = conv_matrix(F, INP(20) + (size_t)lp * D * 4096, D, 4096, WP, 0, 8192, pfx, CP);
                pfx = conv_matrix(F, INP(21) + (size_t)lp * 4096 * D, 4096, D, (bf16*)(F.ws + WS_WMIX + 48 * MiB), 0, 0, pfx, CP);
                if (CP.valid) conv_finish(CP, (LAS float*)(F.lds + RING_OFF + F.wave * 16384), F.lane); }
                if (EN(1)) rmsnorm_phase(F, XOUT, INP(1) + (size_t)li * D, ((bf16*)(F.ws + WS_XN)));
            }
            PH_END;
            FFN_GEMMS(WS_W1GU, WS_W1D, XOUT);
            if (PH_ON && EN(1)) { if (REP(1) > 1) rmsnorm_phase(F, XOUT, INP(5) + (size_t)li * D, ((bf16*)(F.ws + WS_XN))); rmsnorm_phase(F, XOUT, INP(5) + (size_t)li * D, ((bf16*)(F.ws + WS_XN))); }
            PH_END;
            if (PH_ON && EN(8)) {
                pg8::Gemm gg{((bf16*)(F.ws + WS_XN)), (const bf16*)(F.ws + WS_WMIX), M, 12288, D}; pg8::StaticOrder S; S.init(M, 12288, F.G, (int)blockIdx.x);
                pg8::EpiRetProj E{(bf16*)(F.ws + WS_QR), (bf16*)(F.ws + WS_KR), (bf16*)(F.ws + WS_KZT), (bf16*)(F.ws + WS_VT), (bf16*)(F.ws + WS_GS), (const float*)(F.ws + WS_RTAB)};
                pg8::gemm_phase<pg8::EpiRetProj, pg8::StaticOrder, PG8_ALIGN, PG8_SP2>(F.lds + RING_OFF, gg, S, E);
                if (REP(8) > 1) pg8::gemm_phase<pg8::EpiRetProj, pg8::StaticOrder, PG8_ALIGN, PG8_SP2>(F.lds + RING_OFF, gg, S, E);
            }
            PH_END;
            if (PH_ON && EN(9)) for (int rp_ = 0; rp_ < REP(9); ++rp_) ret_scan_phase(F, (const bf16*)(F.ws + WS_KZT), (const bf16*)(F.ws + WS_VT), (bf16*)(F.ws + WS_RT));
            PH_END;
            if (PH_ON && EN(10)) { if (REP(10) > 1) ret_chunk_phase(F, (const bf16*)(F.ws + WS_QR), (const bf16*)(F.ws + WS_KR), (const bf16*)(F.ws + WS_VT), (const bf16*)(F.ws + WS_GS), (const bf16*)(F.ws + WS_RT), (bf16*)(F.ws + WS_END + 4 * MiB));
                ret_chunk_phase(F, (const bf16*)(F.ws + WS_QR), (const bf16*)(F.ws + WS_KR), (const bf16*)(F.ws + WS_VT), (const bf16*)(F.ws + WS_GS), (const bf16*)(F.ws + WS_RT), (bf16*)(F.ws + WS_GS)); }
            PH_END;
            if (PH_ON && EN(11)) { pg8::Gemm gg{(const bf16*)(F.ws + WS_GS), (const bf16*)(F.ws + WS_WMIX + 48 * MiB), M, D, 4096}; pg8::StaticOrder S; S.init(M, D, F.G, (int)blockIdx.x);
                pg8::EpiResid E{XOUT, XOUT, D, 1.0f};
                if (REP(7) > 1) { pg8::EpiResid E2{XOUT, (float*)(F.ws + WS_END + 4 * MiB), D, 1.0f}; pg8::gemm_phase<pg8::EpiResid, pg8::StaticOrder, PG8_ALIGN, PG8_SP2>(F.lds + RING_OFF, gg, S, E2); }
                pg8::gemm_phase<pg8::EpiResid, pg8::StaticOrder, PG8_ALIGN, PG8_SP2>(F.lds + RING_OFF, gg, S, E); }
            PH_END;
            if (PH_ON && EN(1)) { if (REP(1) > 1) rmsnorm_phase(F, XOUT, INP(22) + (size_t)li * D, ((bf16*)(F.ws + WS_XN))); rmsnorm_phase(F, XOUT, INP(22) + (size_t)li * D, ((bf16*)(F.ws + WS_XN))); }
            PH_END;
            FFN_GEMMS(WS_W2GU, WS_W2D, XOUT);
        }
    }
#undef PH_ON
#undef PH_END
#undef FFN_GEMMS
#undef CONV_FFN
__global__ void __launch_bounds__(NWAVES * 64, 2) fwd_kernel(Args args) {
    extern __shared__ __attribute__((aligned(16))) unsigned char lds[];
    Frame F;
    F.lds = (LAS unsigned char*)lds;
    F.MISC = (volatile LAS unsigned*)(F.lds + MISC_OFF);
    F.tid = threadIdx.x; F.lane = F.tid & 63; F.wave = __builtin_amdgcn_readfirstlane(F.tid >> 6);
    F.G = gridDim.x; { const int bx = blockIdx.x; F.vcu = (F.G % 8 == 0) ? (bx % 8) * (F.G / 8) + bx / 8 : bx; }
    F.ws = args.ws; F.ctl = (gu32*)(args.ws + WS_CTL);
    for (int u = F.tid; u < (LDS_BYTES - LDSCTL_OFF) / 4; u += NWAVES * 64) ((LAS unsigned*)(F.lds + LDSCTL_OFF))[u] = 0u;
    __syncthreads();
    const int lo = args.ph_lo, hi = args.ph_hi;
    XcdBarrier bar; bar.bar = (unsigned*)(F.ctl + CW_BAR); bar.x = 0; bar.st = nullptr;
    if (hi - lo > 1) bar = xcd_barrier_post((unsigned*)(F.ctl + CW_BAR), F.MISC + 8);
    int ph = 0;
    layer_pair<0>(args, F, lds, bar, lo, hi, ph);
    layer_pair<1>(args, F, lds, bar, lo, hi, ph);
}

extern "C" void kernel_launch(void* const* d_in, const int* in_sizes, int n_in, void* d_out, int out_size, void* d_ws, size_t ws_size, hipStream_t stream) {
    static int grid = 0;
    if (grid == 0) {
        if (n_in != 26 || in_sizes[0] != M * D || out_size != M * D || ws_size < WS_END) { fprintf(stderr, "kernel_launch: unexpected shapes / workspace (n_in %d, ws %zu)\n", n_in, ws_size); grid = -1; return; }
        int dev = 0, cus = 0, per_cu = 0;
        if (hipGetDevice(&dev) != hipSuccess || hipDeviceGetAttribute(&cus, hipDeviceAttributeMultiprocessorCount, dev) != hipSuccess) { grid = -1; return; }
        if (hipFuncSetAttribute((const void*)fwd_kernel, hipFuncAttributeMaxDynamicSharedMemorySize, LDS_BYTES) != hipSuccess) { fprintf(stderr, "kernel_launch: hipFuncSetAttribute failed\n"); grid = -1; return; }
        if (hipOccupancyMaxActiveBlocksPerMultiprocessor(&per_cu, (const void*)fwd_kernel, NWAVES * 64, LDS_BYTES) != hipSuccess || per_cu < 1) { fprintf(stderr, "kernel_launch: occupancy query reports %d\n", per_cu); }
        (void)hipGetLastError();
        grid = cus;
        if (grid != 256) { fprintf(stderr, "kernel_launch: built for 256 CUs, found %d\n", cus); grid = -1; return; }
    }
    if (grid < 0) return;
    if (hipMemsetAsync((char*)d_ws + WS_CTL, 0, CTL_ZERO_BYTES, stream) != hipSuccess) return;
    Args a{};
    for (int i = 0; i < 26; ++i) a.in[i] = (const float*)d_in[i];
    a.out = (float*)d_out; a.ws = (unsigned char*)d_ws;
#if MK_SPLIT
    for (int p = 0; p < N_PHASES; ++p) { a.ph_lo = p; a.ph_hi = p + 1; hipLaunchKernelGGL(fwd_kernel, dim3(grid), dim3(NWAVES * 64), LDS_BYTES, stream, a); }
#else
    a.ph_lo = 0; a.ph_hi = N_PHASES;
    hipLaunchKernelGGL(fwd_kernel, dim3(grid), dim3(NWAVES * 64), LDS_BYTES, stream, a);
#endif
}
```
